# Optimizing an MI355X kernel written in HIP

```python
import math
import jax, jax.numpy as jnp
from jax import lax
import numpy as np

D_MODEL = 1024
BATCH = 32
SEQ = 2048
DEPTH = 1

GM_HEADS = 8
GM_HEAD_DIM = 128
GM_WIDTH = GM_HEADS * GM_HEAD_DIM
CHUNK = 128
DA_HEADS = 8
DA_QK_DIM = 64
DA_V_DIM = 2 * DA_QK_DIM
DA_WIDTH = DA_HEADS * DA_V_DIM
DA_QK_WIDTH = DA_HEADS * 2 * DA_QK_DIM
ROPE_THETA = 10000.0
Q_BLOCK = 128
EPS = 1e-6

SPLITS = [GM_WIDTH, GM_WIDTH, GM_WIDTH,
          DA_QK_WIDTH, DA_QK_WIDTH, DA_WIDTH, DA_WIDTH,
          D_MODEL, D_MODEL]
D_IN = sum(SPLITS)
SPLIT_POINTS = [int(s) for s in np.cumsum(SPLITS)[:-1]]

kernel_name = "hybrid_gmlp_diffattn_gated_block"


def rmsnorm(x, g):
    xf = x.astype(jnp.float32)
    out = xf * lax.rsqrt(jnp.mean(xf * xf, axis=-1, keepdims=True) + EPS)
    return (out * g.astype(jnp.float32)).astype(x.dtype)


def layernorm(x, g, b):
    xf = x.astype(jnp.float32)
    mu = jnp.mean(xf, axis=-1, keepdims=True)
    var = jnp.mean(jnp.square(xf - mu), axis=-1, keepdims=True)
    out = (xf - mu) * lax.rsqrt(var + EPS) * g.astype(jnp.float32) + b.astype(jnp.float32)
    return out.astype(x.dtype)


def rope(x, cos, sin):
    half = x.shape[-1] // 2
    x1, x2 = x[..., :half], x[..., half:]
    cos = cos.astype(x.dtype)
    sin = sin.astype(x.dtype)
    return jnp.concatenate([x1 * cos - x2 * sin, x2 * cos + x1 * sin], axis=-1)


def gmlp_branch(u, v, ln_g, ln_b, ws, bs):
    B, S, _ = v.shape
    nc = S // CHUNK
    vn = layernorm(v, ln_g, ln_b).reshape(B, nc, CHUNK, GM_HEADS, GM_HEAD_DIM)
    sv = jnp.einsum('hij,bcjhd->bcihd', ws.astype(v.dtype), vn)
    sv = sv + bs.T.astype(v.dtype)[None, None, :, :, None]
    return u * sv.reshape(B, S, GM_WIDTH)


def diff_attention(q, k, v, lq1, lk1, lq2, lk2, subln_g, lam_init, cos, sin):
    B, S, _ = q.shape
    q = q.reshape(B, S, DA_HEADS, 2, DA_QK_DIM)
    k = k.reshape(B, S, DA_HEADS, 2, DA_QK_DIM)
    v = v.reshape(B, S, DA_HEADS, DA_V_DIM)
    scale = DA_QK_DIM ** -0.5
    q1 = rope(q[..., 0, :], cos, sin) * scale
    q2 = rope(q[..., 1, :], cos, sin) * scale
    k1 = rope(k[..., 0, :], cos, sin)
    k2 = rope(k[..., 1, :], cos, sin)
    lam = (jnp.exp(jnp.sum(lq1.astype(jnp.float32) * lk1.astype(jnp.float32)))
           - jnp.exp(jnp.sum(lq2.astype(jnp.float32) * lk2.astype(jnp.float32)))
           + lam_init)
    nb = S // Q_BLOCK
    q1b = q1.reshape(B, nb, Q_BLOCK, DA_HEADS, DA_QK_DIM).transpose(1, 0, 2, 3, 4)
    q2b = q2.reshape(B, nb, Q_BLOCK, DA_HEADS, DA_QK_DIM).transpose(1, 0, 2, 3, 4)

    def block(args):
        a1, a2 = args
        p1 = jax.nn.softmax(jnp.einsum('bqhd,bkhd->bhqk', a1, k1).astype(jnp.float32), axis=-1)
        p2 = jax.nn.softmax(jnp.einsum('bqhd,bkhd->bhqk', a2, k2).astype(jnp.float32), axis=-1)
        attn = (p1 - lam * p2).astype(v.dtype)
        return jnp.einsum('bhqk,bkhe->bqhe', attn, v)

    o = lax.map(block, (q1b, q2b))
    o = o.transpose(1, 0, 2, 3, 4).reshape(B, S, DA_HEADS, DA_V_DIM)
    o = rmsnorm(o, subln_g) * jnp.asarray(1.0 - lam_init, dtype=o.dtype)
    return o.reshape(B, S, DA_WIDTH)


def setup_inputs(seed: int = 0) -> dict:
    key = jax.random.key(seed)
    ks = jax.random.split(key, 16)
    f32 = jnp.float32
    n = lambda k, shape: jax.random.normal(k, shape, dtype=f32)
    return {
        "x": n(ks[0], (BATCH, SEQ, D_MODEL)),
        "ln_pre_g": 1.0 + 0.05 * n(ks[1], (DEPTH, D_MODEL)),
        "w_in": n(ks[2], (DEPTH, D_MODEL, D_IN)) * D_MODEL ** -0.5,
        "gm_ln_g": 1.0 + 0.05 * n(ks[3], (DEPTH, GM_WIDTH)),
        "gm_ln_b": 0.05 * n(ks[4], (DEPTH, GM_WIDTH)),
        "gm_ws": n(ks[5], (DEPTH, GM_HEADS, CHUNK, CHUNK)) * CHUNK ** -0.5,
        "gm_bs": 1.0 + 0.1 * n(ks[6], (DEPTH, GM_HEADS, CHUNK)),
        "lambda_q1": 0.1 * n(ks[7], (DEPTH, DA_QK_DIM)),
        "lambda_k1": 0.1 * n(ks[8], (DEPTH, DA_QK_DIM)),
        "lambda_q2": 0.1 * n(ks[9], (DEPTH, DA_QK_DIM)),
        "lambda_k2": 0.1 * n(ks[10], (DEPTH, DA_QK_DIM)),
        "da_subln_g": 1.0 + 0.05 * n(ks[11], (DEPTH, DA_V_DIM)),
        "w_branch_a": n(ks[12], (DEPTH, GM_WIDTH, D_MODEL)) * GM_WIDTH ** -0.5,
        "w_branch_b": n(ks[13], (DEPTH, DA_WIDTH, D_MODEL)) * DA_WIDTH ** -0.5,
        "w_out": n(ks[14], (DEPTH, D_MODEL, D_MODEL)) * D_MODEL ** -0.5,
        "ln_post_g": 1.0 + 0.05 * n(ks[15], (DEPTH, D_MODEL)),
    }


def reference(x, ln_pre_g, w_in, gm_ln_g, gm_ln_b, gm_ws, gm_bs, lambda_q1, lambda_k1,
              lambda_q2, lambda_k2, da_subln_g, w_branch_a, w_branch_b, w_out, ln_post_g):
    S = x.shape[1]
    pos = jnp.arange(S, dtype=jnp.float32)
    inv_freq = 1.0 / (ROPE_THETA ** (jnp.arange(0, DA_QK_DIM, 2, dtype=jnp.float32) / DA_QK_DIM))
    ang = pos[:, None] * inv_freq[None, :]
    cos = jnp.cos(ang)[:, None, :]
    sin = jnp.sin(ang)[:, None, :]
    for l in range(DEPTH):
        lam_init = 0.8 - 0.6 * math.exp(-0.3 * l)
        h = rmsnorm(x, ln_pre_g[l])
        proj = jnp.einsum('bsd,de->bse', h, w_in[l])
        u, v, za, q, k, vv, zb, ga, gb = jnp.split(proj, SPLIT_POINTS, axis=-1)
        ya = gmlp_branch(u, v, gm_ln_g[l], gm_ln_b[l], gm_ws[l], gm_bs[l]) * jax.nn.silu(za)
        yb = diff_attention(q, k, vv, lambda_q1[l], lambda_k1[l], lambda_q2[l], lambda_k2[l],
                            da_subln_g[l], lam_init, cos, sin) * jax.nn.silu(zb)
        merged = (jax.nn.sigmoid(ga) * jnp.einsum('bse,ed->bsd', ya, w_branch_a[l])
                  + jax.nn.sigmoid(gb) * jnp.einsum('bse,ed->bsd', yb, w_branch_b[l]))
        out = jnp.einsum('bsd,de->bse', merged, w_out[l])
        x = x + rmsnorm(out, ln_post_g[l])
    return x
```

```cpp
#include <hip/hip_runtime.h>
#include <hip/hip_cooperative_groups.h>
#include <cstdio>
#include <cstdint>
namespace cg = cooperative_groups;
namespace pg8 {
#define PG8_LAS __attribute__((address_space(3)))
typedef unsigned short bf16_t;
typedef short bf16x8 __attribute__((ext_vector_type(8)));
typedef float f32x4 __attribute__((ext_vector_type(4)));
typedef unsigned u32x4 __attribute__((ext_vector_type(4)));
constexpr int BM = 256, BK = 64, HALF = 128, HTB = HALF * BK * 2  , STAGE_BYTES = 8 * HTB, NXCD = 8, WGM = 8;

__host__ __device__ __forceinline__ int lds_byte(int r, int c) { const int st = (r >> 4) * 2 + (c >> 5), rr = r & 15, cc = c & 31, ob = rr * 64 + cc * 2; return st * 1024 + (ob ^ (((ob >> 9) & 1) << 5)); }
__host__ __device__ __forceinline__ void stage_rc(int b, int& R, int& C) { const int st = b / 1024, sb = b % 1024, swz = sb ^ (((sb >> 9) & 1) << 5); R = (st >> 1) * 16 + swz / 64; C = (st & 1) * 32 + (swz % 64) / 2; }
__host__ __device__ __forceinline__ int perm32(int rho) { const int n = rho >> 4, i = rho & 15; return 8 * (i >> 2) + 4 * n + (i & 3); }

struct Unit { int pm, pn; };
struct Gemm { const bf16_t* A; const bf16_t* Bt; int M, N, K; };

struct StaticOrder {
    int nM, nN, nwg, G, c;
    __host__ __device__ void init(int M, int N, int G_, int c_) { nM = M / BM; nN = N / BM; nwg = nM * nN; G = G_; c = c_; }
    __host__ __device__ bool next(int i, Unit& u) const {
        const long L = (long)i * G + c; if (L >= nwg) return false;
        int wgid = (int)L; { const int q = nwg / NXCD, r = nwg % NXCD, xcd = wgid % NXCD, off = wgid / NXCD; wgid = (xcd < r ? xcd * (q + 1) : r * (q + 1) + (xcd - r) * q) + off; }
        const int nig = WGM * nN, gid = wgid / nig, fm = gid * WGM, gsz = (nM - fm) < WGM ? (nM - fm) : WGM;
        u.pm = fm + ((wgid % nig) % gsz); u.pn = (wgid % nig) / gsz; return true;
    }
    __device__ __forceinline__ void a_ready(const Unit&) const {}
    __device__ __forceinline__ void done(const Unit&) const {}
};

template <class Epi, class Sched, bool ALIGN_EPI = false, bool SP2 = false>
__device__ __forceinline__ void gemm_phase(PG8_LAS unsigned char* lds, const Gemm g, const Sched& S, const Epi& E) {
    int tid_l = threadIdx.x; asm volatile("" : "+v"(tid_l));
    const int tid = tid_l, wid = __builtin_amdgcn_readfirstlane(tid >> 6), lane = tid & 63, wr = wid >> 2, wc = wid & 3, fr = lane & 15, fq = lane >> 4;
    const int K = g.K, nt = K / BK;
    unsigned voffA[2], voffB[2];
#pragma unroll
    for (int i = 0; i < 2; ++i) { int R, C; stage_rc(tid * 16 + i * 8192, R, C); const int Rb = Epi::PERM ? ((R & ~31) + perm32(R & 31)) : R;
        voffA[i] = (unsigned)(R * K + C) * 2u; voffB[i] = (unsigned)(Rb * K + C) * 2u; }
    const size_t kstep = (size_t)(BK * 2);
    const size_t hstep = (size_t)HALF * K * 2;
    const size_t tstep = 2 * hstep;
    const unsigned ldsw = (unsigned)wid * 1024u;
    const int aoff = lds_byte(wr * 64 + fr, fq * 8), boff = lds_byte(wc * 32 + fr, fq * 8);
#define PG8_SA(b, h) (((b) * 2 + (h)) * HTB)
#define PG8_SB(b, h) ((4 + (b) * 2 + (h)) * HTB)
#define PG8_STAGE(bufoff, gbase, voff) do { _Pragma("unroll") for (int _i = 0; _i < 2; ++_i) \
        __builtin_amdgcn_global_load_lds((const unsigned*)((const char*)(gbase) + (voff)[_i]), (PG8_LAS unsigned*)(lds + (bufoff) + ldsw + _i * 8192), 16, 0, 0); } while (0)
#define PG8_LDA(dst, b, h) do { _Pragma("unroll") for (int m = 0; m < 4; ++m) _Pragma("unroll") for (int k = 0; k < 2; ++k) dst[m][k] = *(const PG8_LAS bf16x8*)(lds + PG8_SA(b, h) + aoff + m * 2048 + k * 1024); } while (0)
#define PG8_LDB(dst, b, h) do { _Pragma("unroll") for (int n = 0; n < 2; ++n) _Pragma("unroll") for (int k = 0; k < 2; ++k) dst[n][k] = *(const PG8_LAS bf16x8*)(lds + PG8_SB(b, h) + boff + n * 2048 + k * 1024); } while (0)
#define PG8_MMA(ai, bj, At, Bt) do { __builtin_amdgcn_s_setprio(1); _Pragma("unroll") for (int m = 0; m < 4; ++m) _Pragma("unroll") for (int n = 0; n < 2; ++n) _Pragma("unroll") for (int k = 0; k < 2; ++k) \
        acc[ai][bj][m][n] = __builtin_amdgcn_mfma_f32_16x16x32_bf16(Bt[n][k], At[m][k], acc[ai][bj][m][n], 0, 0, 0); __builtin_amdgcn_s_setprio(0); } while (0)
#define PG8_WAIT_V(n) asm volatile("s_waitcnt vmcnt(" #n ")" ::: "memory")
#define PG8_WAIT_L(n) asm volatile("s_waitcnt lgkmcnt(" #n ")" ::: "memory")
#define PG8_BAR __builtin_amdgcn_s_barrier()
#define PG8_SCHED __builtin_amdgcn_sched_barrier(0)
    Unit cur, nxt; int ui = 0;
    if (!S.next(0, cur)) return;
    f32x4 acc[2][2][4][2];
#pragma unroll
    for (int a = 0; a < 2; ++a)
#pragma unroll
        for (int b = 0; b < 2; ++b)
#pragma unroll
            for (int m = 0; m < 4; ++m)
#pragma unroll
                for (int n = 0; n < 2; ++n) acc[a][b][m][n] = (f32x4){0.f, 0.f, 0.f, 0.f};
    bf16x8 At[4][2], B0[2][2], B1[2][2];
    const char* cA = (const char*)g.A + (size_t)cur.pm * tstep; const char* cB = (const char*)g.Bt + (size_t)cur.pn * tstep;
    S.a_ready(cur);
    if constexpr (SP2) {
        PG8_STAGE(PG8_SB(0, 0), cB, voffB); PG8_STAGE(PG8_SB(0, 1), cB + hstep, voffB); PG8_STAGE(PG8_SA(0, 0), cA, voffA); PG8_STAGE(PG8_SA(0, 1), cA + hstep, voffA);
        if (wr == 1) PG8_BAR;
        PG8_WAIT_V(2); PG8_BAR;
        PG8_STAGE(PG8_SB(1, 0), cB + kstep, voffB); PG8_STAGE(PG8_SA(1, 0), cA + kstep, voffA); PG8_STAGE(PG8_SB(1, 1), cB + hstep + kstep, voffB);
        PG8_WAIT_V(6); PG8_BAR;
    } else {
        PG8_STAGE(PG8_SB(0, 0), cB, voffB); PG8_STAGE(PG8_SA(0, 0), cA, voffA); PG8_STAGE(PG8_SB(0, 1), cB + hstep, voffB); PG8_STAGE(PG8_SA(0, 1), cA + hstep, voffA);
        if (wr == 1) PG8_BAR;
        PG8_WAIT_V(4); PG8_BAR;
        PG8_STAGE(PG8_SB(1, 0), cB + kstep, voffB); PG8_STAGE(PG8_SA(1, 0), cA + kstep, voffA); PG8_STAGE(PG8_SB(1, 1), cB + hstep + kstep, voffB);
        PG8_WAIT_V(6); PG8_BAR;
    }
    for (;;) {
        const bool has_next = S.next(ui + 1, nxt);
        const char* nA = has_next ? (const char*)g.A + (size_t)nxt.pm * tstep : cA; const char* nB = has_next ? (const char*)g.Bt + (size_t)nxt.pn * tstep : cB;
        for (int t = 0; t < nt; t += 2) {
            const bool last = (t == nt - 2);
            const char* a1 = cA + (size_t)(t + 1) * kstep;
            const char* a2 = last ? nA : cA + (size_t)(t + 2) * kstep; const char* b2 = last ? nB : cB + (size_t)(t + 2) * kstep;
            const char* a3 = a2 + kstep; const char* b3 = b2 + kstep;
            if (last && has_next) S.a_ready(nxt);
            if constexpr (SP2) {
            PG8_LDB(B0, 0, 0); PG8_LDB(B1, 0, 1); PG8_SCHED; PG8_LDA(At, 0, 0); PG8_STAGE(PG8_SA(1, 1), a1 + hstep, voffA);
            PG8_WAIT_V(8); PG8_WAIT_L(0); PG8_BAR; PG8_MMA(0, 0, At, B0); PG8_MMA(0, 1, At, B1); PG8_BAR; PG8_SCHED;
            PG8_LDA(At, 0, 1); PG8_STAGE(PG8_SB(0, 0), b2, voffB); PG8_STAGE(PG8_SB(0, 1), b2 + hstep, voffB); PG8_STAGE(PG8_SA(0, 0), a2, voffA);
            PG8_WAIT_V(8); PG8_WAIT_L(0); PG8_BAR; PG8_MMA(1, 0, At, B0); PG8_MMA(1, 1, At, B1); PG8_BAR; PG8_SCHED;
            PG8_LDB(B0, 1, 0); PG8_LDB(B1, 1, 1); PG8_SCHED; PG8_LDA(At, 1, 0); PG8_STAGE(PG8_SA(0, 1), a2 + hstep, voffA);
            PG8_WAIT_V(8); PG8_WAIT_L(0); PG8_BAR; PG8_MMA(0, 0, At, B0); PG8_MMA(0, 1, At, B1); PG8_BAR; PG8_SCHED;
            PG8_LDA(At, 1, 1); PG8_STAGE(PG8_SB(1, 0), b3, voffB); PG8_STAGE(PG8_SB(1, 1), b3 + hstep, voffB); PG8_STAGE(PG8_SA(1, 0), a3, voffA);
            PG8_WAIT_V(8); PG8_WAIT_L(0); PG8_BAR; PG8_MMA(1, 0, At, B0); PG8_MMA(1, 1, At, B1); PG8_BAR; PG8_SCHED;
            } else {
            PG8_LDB(B0, 0, 0); PG8_SCHED; PG8_LDA(At, 0, 0); PG8_STAGE(PG8_SA(1, 1), a1 + hstep, voffA);
            PG8_WAIT_L(8); PG8_BAR; PG8_WAIT_L(0); PG8_MMA(0, 0, At, B0); PG8_BAR; PG8_SCHED;
            PG8_LDB(B1, 0, 1); PG8_STAGE(PG8_SB(0, 0), b2, voffB);
            PG8_BAR; PG8_WAIT_L(0); PG8_MMA(0, 1, At, B1); PG8_BAR;
            PG8_LDA(At, 0, 1); PG8_STAGE(PG8_SA(0, 0), a2, voffA);
            PG8_BAR; PG8_WAIT_L(0); PG8_MMA(1, 0, At, B0); PG8_BAR; PG8_SCHED;
            PG8_STAGE(PG8_SB(0, 1), b2 + hstep, voffB);
            PG8_WAIT_V(6); PG8_BAR; PG8_MMA(1, 1, At, B1); PG8_BAR;
            PG8_LDB(B0, 1, 0); PG8_SCHED; PG8_LDA(At, 1, 0); PG8_STAGE(PG8_SA(0, 1), a2 + hstep, voffA);
            PG8_WAIT_L(8); PG8_BAR; PG8_WAIT_L(0); PG8_MMA(0, 0, At, B0); PG8_BAR; PG8_SCHED;
            PG8_LDB(B1, 1, 1); PG8_STAGE(PG8_SB(1, 0), b3, voffB);
            PG8_BAR; PG8_WAIT_L(0); PG8_MMA(0, 1, At, B1); PG8_BAR;
            PG8_LDA(At, 1, 1); PG8_STAGE(PG8_SA(1, 0), a3, voffA);
            PG8_BAR; PG8_WAIT_L(0); PG8_MMA(1, 0, At, B0); PG8_BAR; PG8_SCHED;
            PG8_STAGE(PG8_SB(1, 1), b3 + hstep, voffB);
            PG8_WAIT_V(6); PG8_BAR; PG8_MMA(1, 1, At, B1); PG8_BAR;
            }
        }
        if constexpr (ALIGN_EPI) { if (wr == 0) PG8_BAR; }
        if constexpr (!Epi::AFTER_DRAIN) { E(acc, cur, wr, wc, fr, fq); S.done(cur); }
        if (!has_next) break;
#pragma unroll
        for (int a = 0; a < 2; ++a)
#pragma unroll
            for (int b = 0; b < 2; ++b)
#pragma unroll
                for (int m = 0; m < 4; ++m)
#pragma unroll
                    for (int n = 0; n < 2; ++n) acc[a][b][m][n] = (f32x4){0.f, 0.f, 0.f, 0.f};
        cur = nxt; cA = nA; cB = nB; ++ui;
        if constexpr (ALIGN_EPI) { if (wr == 1) PG8_BAR; }
    }
    PG8_WAIT_V(0);
    if constexpr (!ALIGN_EPI) { if (wr == 0) PG8_BAR; }
    PG8_BAR;
    if constexpr (Epi::AFTER_DRAIN) { E.fused(acc, cur, wr, wc, fr, fq, lds, wid, lane); S.done(cur); }
#undef PG8_SA
#undef PG8_SB
#undef PG8_STAGE
#undef PG8_LDA
#undef PG8_LDB
#undef PG8_MMA
#undef PG8_WAIT_V
#undef PG8_WAIT_L
#undef PG8_BAR
#undef PG8_SCHED
}
}
#ifndef MK_N_LAUNCHES
#define MK_N_LAUNCHES 1
#endif
#define LAS __attribute__((address_space(3)))
using pg8::bf16_t; using pg8::bf16x8; using pg8::f32x4; using pg8::u32x4;
typedef float f32x16 __attribute__((ext_vector_type(16)));
typedef unsigned u32x2 __attribute__((ext_vector_type(2)));

constexpr int DMOD = 1024, SEQ = 2048, NB = 32, MTOT = NB * SEQ, BPG = 8, MG = BPG * SEQ, NGROUP = NB / BPG;
constexpr int NMAIN = 8192;
constexpr float EPS = 1e-6f;
constexpr float C2 = 0.125f * 1.4426950408889634f;
constexpr float LAM_INIT = 0.2f;
constexpr size_t MiB = 1u << 20;
constexpr size_t WS_WMAIN = 1 * MiB, WS_WVV = 17 * MiB, WS_WA = 19 * MiB, WS_WB = 21 * MiB, WS_WOUT = 23 * MiB, WS_GMWS = 25 * MiB,
                 WS_ROPE = 25 * MiB + 256 * 1024, WS_LNSUM = 26 * MiB, WS_ROWSS = 26 * MiB + 512 * 1024, WS_XN = 32 * MiB,
                 WS_PROJ = 160 * MiB, SEG_BYTES = 32 * MiB, WS_VT = 416 * MiB, WS_YA = 448 * MiB, WS_YB = 480 * MiB,
                 WS_TMP = 512 * MiB, WS_MERGED = 576 * MiB, WS_END = 608 * MiB;
constexpr size_t SEG_ELEMS = (size_t)MG * 1024;
enum { SEG_U = 0, SEG_V = 1, SEG_ZA = 2, SEG_Q = 3, SEG_K = 4, SEG_ZB = 5, SEG_GA = 6, SEG_GB = 7 };
constexpr int LDS_BYTES = 147456;

__device__ __forceinline__ unsigned pkbf(float lo, float hi) {
    typedef float f2 __attribute__((ext_vector_type(2))); typedef __bf16 b2 __attribute__((ext_vector_type(2)));
    f2 v = {lo, hi}; b2 b = __builtin_convertvector(v, b2); return __builtin_bit_cast(unsigned, b);
}
__device__ __forceinline__ float bflo(unsigned w) { return __uint_as_float(w << 16); }
__device__ __forceinline__ float bfhi(unsigned w) { return __uint_as_float(w & 0xffff0000u); }
__device__ __forceinline__ u32x4 pack8(f32x4 a, f32x4 b) { u32x4 w; w.x = pkbf(a[0], a[1]); w.y = pkbf(a[2], a[3]); w.z = pkbf(b[0], b[1]); w.w = pkbf(b[2], b[3]); return w; }
__device__ __forceinline__ float sigm(float x) { return __builtin_amdgcn_rcpf(1.f + __expf(-x)); }
__device__ __forceinline__ float wave_sum(float v) {
#pragma unroll
    for (int o = 1; o < 64; o <<= 1) v += __shfl_xor(v, o);
    return v;
}

struct EpiProj {
    static constexpr bool PERM = true, AFTER_DRAIN = false;
    bf16_t* base; const float* rope; float* lnsum;
    __device__ __forceinline__ void operator()(const f32x4 (&acc)[2][2][4][2], const pg8::Unit& u, int wr, int wc, int fr, int fq) const {
        const int seg = u.pn >> 2;
        bf16_t* O = base + (size_t)seg * SEG_ELEMS;
        const int col0 = (u.pn & 3) * 256 + wc * 32 + 8 * fq;
        const int row0 = u.pm * 256 + wr * 64 + fr;
        const int mode = (seg == SEG_ZA || seg == SEG_ZB) ? 1 : (seg >= SEG_GA ? 2 : ((seg == SEG_Q || seg == SEG_K) ? 3 : (seg == SEG_V ? 4 : 0)));
        const float qs = (seg == SEG_Q) ? C2 : 1.f;
#pragma unroll
        for (int ai = 0; ai < 2; ++ai)
#pragma unroll
            for (int m = 0; m < 4; ++m) {
                const int row = row0 + ai * 128 + m * 16;
                f32x4 cs0 = {1.f, 0.f, 1.f, 0.f}, cs1 = cs0;
                if (mode == 3) { const float* rp = rope + ((size_t)(row & (SEQ - 1)) * 32 + ((wc & 1) * 16 + 4 * fq)) * 2; cs0 = *(const f32x4*)rp; cs1 = *(const f32x4*)(rp + 4); }
                float s = 0.f, q = 0.f;
#pragma unroll
                for (int bj = 0; bj < 2; ++bj) {
                    f32x4 v0 = acc[ai][bj][m][0], v1 = acc[ai][bj][m][1];
                    if (mode == 1) {
#pragma unroll
                        for (int e = 0; e < 4; ++e) { v0[e] = v0[e] * sigm(v0[e]); v1[e] = v1[e] * sigm(v1[e]); }
                    } else if (mode == 2) {
#pragma unroll
                        for (int e = 0; e < 4; ++e) { v0[e] = sigm(v0[e]); v1[e] = sigm(v1[e]); }
                    } else if (mode == 3) {
                        f32x4 a, b;
                        a[0] = (v0[0] * cs0[0] - v0[1] * cs0[1]) * qs; a[1] = (v0[1] * cs0[0] + v0[0] * cs0[1]) * qs;
                        a[2] = (v0[2] * cs0[2] - v0[3] * cs0[3]) * qs; a[3] = (v0[3] * cs0[2] + v0[2] * cs0[3]) * qs;
                        b[0] = (v1[0] * cs1[0] - v1[1] * cs1[1]) * qs; b[1] = (v1[1] * cs1[0] + v1[0] * cs1[1]) * qs;
                        b[2] = (v1[2] * cs1[2] - v1[3] * cs1[3]) * qs; b[3] = (v1[3] * cs1[2] + v1[2] * cs1[3]) * qs;
                        v0 = a; v1 = b;
                    } else if (mode == 4) {
#pragma unroll
                        for (int e = 0; e < 4; ++e) { s += v0[e] + v1[e]; q += v0[e] * v0[e] + v1[e] * v1[e]; }
                    }
                    *(u32x4*)(O + (size_t)row * 1024 + col0 + bj * 128) = pack8(v0, v1);
                }
                if (mode == 4) {
                    s += __shfl_xor(s, 16); s += __shfl_xor(s, 32); q += __shfl_xor(q, 16); q += __shfl_xor(q, 32);
                    if (fq == 0) { unsafeAtomicAdd(lnsum + (size_t)row * 2, s); unsafeAtomicAdd(lnsum + (size_t)row * 2 + 1, q); }
                }
                asm volatile("" ::: "memory");
            }
    }
};
struct EpiPlain {
    static constexpr bool PERM = true, AFTER_DRAIN = false;
    bf16_t* O; int ldc;
    __device__ __forceinline__ void operator()(const f32x4 (&acc)[2][2][4][2], const pg8::Unit& u, int wr, int wc, int fr, int fq) const {
        const int col0 = u.pn * 256 + wc * 32 + 8 * fq, row0 = u.pm * 256 + wr * 64 + fr;
#pragma unroll
        for (int ai = 0; ai < 2; ++ai)
#pragma unroll
            for (int m = 0; m < 4; ++m)
#pragma unroll
                for (int bj = 0; bj < 2; ++bj)
                    *(u32x4*)(O + (size_t)(row0 + ai * 128 + m * 16) * ldc + col0 + bj * 128) = pack8(acc[ai][bj][m][0], acc[ai][bj][m][1]);
    }
};
struct EpiGateA {
    static constexpr bool PERM = true, AFTER_DRAIN = false;
    const bf16_t* G; float* T;
    __device__ __forceinline__ void operator()(const f32x4 (&acc)[2][2][4][2], const pg8::Unit& u, int wr, int wc, int fr, int fq) const {
        const int col0 = u.pn * 256 + wc * 32 + 8 * fq, row0 = u.pm * 256 + wr * 64 + fr;
#pragma unroll
        for (int ai = 0; ai < 2; ++ai)
#pragma unroll
            for (int m = 0; m < 4; ++m)
#pragma unroll
                for (int bj = 0; bj < 2; ++bj) {
                    const size_t off = (size_t)(row0 + ai * 128 + m * 16) * 1024 + col0 + bj * 128;
                    const u32x4 g = *(const u32x4*)(G + off);
                    f32x4 v0 = acc[ai][bj][m][0], v1 = acc[ai][bj][m][1];
                    v0[0] *= bflo(g.x); v0[1] *= bfhi(g.x); v0[2] *= bflo(g.y); v0[3] *= bfhi(g.y);
                    v1[0] *= bflo(g.z); v1[1] *= bfhi(g.z); v1[2] *= bflo(g.w); v1[3] *= bfhi(g.w);
                    *(f32x4*)(T + off) = v0; *(f32x4*)(T + off + 4) = v1;
                    asm volatile("" ::: "memory");
                }
    }
};
struct EpiGateB {
    static constexpr bool PERM = true, AFTER_DRAIN = false;
    const bf16_t* G; const float* T; bf16_t* O;
    __device__ __forceinline__ void operator()(const f32x4 (&acc)[2][2][4][2], const pg8::Unit& u, int wr, int wc, int fr, int fq) const {
        const int col0 = u.pn * 256 + wc * 32 + 8 * fq, row0 = u.pm * 256 + wr * 64 + fr;
#pragma unroll
        for (int ai = 0; ai < 2; ++ai)
#pragma unroll
            for (int m = 0; m < 4; ++m)
#pragma unroll
                for (int bj = 0; bj < 2; ++bj) {
                    const size_t off = (size_t)(row0 + ai * 128 + m * 16) * 1024 + col0 + bj * 128;
                    const u32x4 g = *(const u32x4*)(G + off);
                    f32x4 v0 = acc[ai][bj][m][0], v1 = acc[ai][bj][m][1];
                    const f32x4 t0 = *(const f32x4*)(T + off), t1 = *(const f32x4*)(T + off + 4);
                    v0[0] = t0[0] + v0[0] * bflo(g.x); v0[1] = t0[1] + v0[1] * bfhi(g.x); v0[2] = t0[2] + v0[2] * bflo(g.y); v0[3] = t0[3] + v0[3] * bfhi(g.y);
                    v1[0] = t1[0] + v1[0] * bflo(g.z); v1[1] = t1[1] + v1[1] * bfhi(g.z); v1[2] = t1[2] + v1[2] * bflo(g.w); v1[3] = t1[3] + v1[3] * bfhi(g.w);
                    *(u32x4*)(O + off) = pack8(v0, v1);
                    asm volatile("" ::: "memory");
                }
    }
};
struct EpiOut {
    static constexpr bool PERM = true, AFTER_DRAIN = false;
    float* O; float* rowss;
    __device__ __forceinline__ void operator()(const f32x4 (&acc)[2][2][4][2], const pg8::Unit& u, int wr, int wc, int fr, int fq) const {
        const int col0 = u.pn * 256 + wc * 32 + 8 * fq, row0 = u.pm * 256 + wr * 64 + fr;
#pragma unroll
        for (int ai = 0; ai < 2; ++ai)
#pragma unroll
            for (int m = 0; m < 4; ++m) {
                const int row = row0 + ai * 128 + m * 16; float q = 0.f;
#pragma unroll
                for (int bj = 0; bj < 2; ++bj) {
                    const f32x4 v0 = acc[ai][bj][m][0], v1 = acc[ai][bj][m][1];
                    float* p = O + (size_t)row * 1024 + col0 + bj * 128;
                    *(f32x4*)p = v0; *(f32x4*)(p + 4) = v1;
#pragma unroll
                    for (int e = 0; e < 4; ++e) q += v0[e] * v0[e] + v1[e] * v1[e];
                }
                q += __shfl_xor(q, 16); q += __shfl_xor(q, 32);
                if (fq == 0) unsafeAtomicAdd(rowss + row, q);
            }
    }
};

namespace att {
constexpr int KROW = 272, VROW = 144, KBUF = 64 * KROW, VBUF = 128 * VROW, BUFB = KBUF + VBUF;
constexpr int OFF_Q = 2 * BUFB, QW = 32 * KROW, OFF_WSF = OFF_Q + 8 * QW;
static_assert(OFF_WSF + 8 * 256 <= LDS_BYTES, "attention LDS map");
constexpr float THR = 8.f;
__device__ __forceinline__ int crow(int r, int hi) { return (r & 3) + 8 * (r >> 2) + 4 * hi; }
#define MFMA32(a, b, c) __builtin_amdgcn_mfma_f32_32x32x16_bf16((a), (b), (c), 0, 0, 0)

__device__ __forceinline__ void attn_unit(LAS unsigned char* lds, const bf16_t* __restrict__ Q, const bf16_t* __restrict__ K, const bf16_t* __restrict__ Vt,
                                          const bf16_t* __restrict__ ZB, bf16_t* __restrict__ YB, const float* __restrict__ subg, float lam, int bl, int h, int qb) {
    int tid_l = threadIdx.x; asm volatile("" : "+v"(tid_l));
    const int tid = tid_l, lane = tid & 63, wid = __builtin_amdgcn_readfirstlane(tid >> 6), r32 = lane & 31, hi = lane >> 5;
    const size_t rowq0 = (size_t)bl * SEQ + qb * 256 + wid * 32;
    LAS unsigned char* qlds = lds + OFF_Q + wid * QW;
    LAS float* wsf = (LAS float*)(lds + OFF_WSF + wid * 256);
#pragma unroll
    for (int i = 0; i < 8; ++i) { const int p = lane + 64 * i, row = p >> 4, ch = p & 15;
        const u32x4 v = *(const u32x4*)(Q + (rowq0 + row) * 1024 + h * 128 + ch * 8); *(LAS u32x4*)(qlds + row * KROW + ch * 16) = v; }
    const bf16_t* Kg = K + ((size_t)bl * SEQ) * 1024 + h * 128;
    const bf16_t* Vg = Vt + (size_t)(h * 128) * MG + (size_t)bl * SEQ;
    const int kr0 = tid >> 4, kc = tid & 15, vr0 = tid >> 3, vc = tid & 7;
    u32x4 sk0, sk1, sv0, sv1;
#define ATT_LOADK(t) do { const bf16_t* kp = Kg + (size_t)((t) * 64 + kr0) * 1024 + kc * 8; sk0 = *(const u32x4*)kp; sk1 = *(const u32x4*)(kp + 32 * 1024); } while (0)
#define ATT_LOADV(t) do { const bf16_t* vp = Vg + (size_t)vr0 * MG + (t) * 64 + vc * 8; sv0 = *(const u32x4*)vp; sv1 = *(const u32x4*)(vp + (size_t)64 * MG); } while (0)
#define ATT_WRITEK(b) do { LAS unsigned char* kb_ = lds + (b) * BUFB; *(LAS u32x4*)(kb_ + kr0 * KROW + kc * 16) = sk0; *(LAS u32x4*)(kb_ + (kr0 + 32) * KROW + kc * 16) = sk1; } while (0)
#define ATT_WRITEV(b) do { LAS unsigned char* kb_ = lds + (b) * BUFB; *(LAS u32x4*)(kb_ + KBUF + vr0 * VROW + vc * 16) = sv0; *(LAS u32x4*)(kb_ + KBUF + (vr0 + 64) * VROW + vc * 16) = sv1; } while (0)
    ATT_LOADK(0); ATT_LOADV(0); ATT_WRITEK(0); ATT_WRITEV(0);
    __syncthreads();
    f32x16 o[2][4];
#pragma unroll
    for (int mp = 0; mp < 2; ++mp)
#pragma unroll
        for (int eb = 0; eb < 4; ++eb)
#pragma unroll
            for (int r = 0; r < 16; ++r) o[mp][eb][r] = 0.f;
    float mref[2] = {0.f, 0.f}, lsum[2] = {0.f, 0.f};
    const int pi = (r32 & ~12) | ((r32 & 4) << 1) | ((r32 & 8) >> 1);
    const int koff = pi * KROW + hi * 16, qoff = r32 * KROW + hi * 16, voff = r32 * VROW + hi * 16;
    constexpr int NT = SEQ / 64;
#pragma unroll 1
    for (int t = 0; t < NT; ++t) {
        const int cur = t & 1;
        if (t + 1 < NT) ATT_LOADK(t + 1);
        LAS unsigned char* kb = lds + cur * BUFB; LAS unsigned char* vb = kb + KBUF;
        bf16x8 P[2][4];
#pragma unroll
        for (int mp = 0; mp < 2; ++mp) {
            bf16x8 qf[4];
#pragma unroll
            for (int ks = 0; ks < 4; ++ks) qf[ks] = *(LAS bf16x8*)(qlds + qoff + mp * 128 + ks * 32);
#pragma unroll
            for (int blk = 0; blk < 2; ++blk) {
                f32x16 s;
#pragma unroll
                for (int r = 0; r < 16; ++r) s[r] = 0.f;
#pragma unroll
                for (int ks = 0; ks < 4; ++ks) { const bf16x8 kf = *(LAS bf16x8*)(kb + blk * 32 * KROW + koff + mp * 128 + ks * 32); s = MFMA32(kf, qf[ks], s); }
                float rm = fmaxf(s[0], s[1]);
#pragma unroll
                for (int r = 2; r < 16; ++r) rm = fmaxf(rm, s[r]);
                rm = fmaxf(rm, __shfl_xor(rm, 32));
                const bool first = (t == 0 && blk == 0);
                if (first || __any(rm > mref[mp] + THR)) {
                    const float mnew = first ? rm : fmaxf(mref[mp], rm);
                    if (!first) {
                        const float alpha = __builtin_amdgcn_exp2f(mref[mp] - mnew);
                        lsum[mp] *= alpha;
                        if (hi == 0) wsf[r32] = alpha;
#pragma unroll
                        for (int r = 0; r < 16; ++r) { const float al = wsf[crow(r, hi)];
#pragma unroll
                            for (int eb = 0; eb < 4; ++eb) o[mp][eb][r] *= al; }
                        if (blk == 1) {
#pragma unroll
                            for (int j = 0; j < 2; ++j) { u32x4 w = __builtin_bit_cast(u32x4, P[mp][j]);
                                w.x = pkbf(bflo(w.x) * alpha, bfhi(w.x) * alpha); w.y = pkbf(bflo(w.y) * alpha, bfhi(w.y) * alpha);
                                w.z = pkbf(bflo(w.z) * alpha, bfhi(w.z) * alpha); w.w = pkbf(bflo(w.w) * alpha, bfhi(w.w) * alpha); P[mp][j] = __builtin_bit_cast(bf16x8, w); }
                        }
                    }
                    mref[mp] = mnew;
                }
                const float mm = mref[mp]; float ps = 0.f;
#pragma unroll
                for (int r = 0; r < 16; ++r) { const float p = __builtin_amdgcn_exp2f(s[r] - mm); s[r] = p; ps += p; }
                lsum[mp] += ps;
#pragma unroll
                for (int j = 0; j < 2; ++j) { u32x4 w; w.x = pkbf(s[8 * j], s[8 * j + 1]); w.y = pkbf(s[8 * j + 2], s[8 * j + 3]);
                    w.z = pkbf(s[8 * j + 4], s[8 * j + 5]); w.w = pkbf(s[8 * j + 6], s[8 * j + 7]); P[mp][2 * blk + j] = __builtin_bit_cast(bf16x8, w); }
            }
            __builtin_amdgcn_sched_barrier(0);
        }
        if (t + 1 < NT) { ATT_WRITEK(cur ^ 1); ATT_LOADV(t + 1); }
        __builtin_amdgcn_sched_barrier(0);
#pragma unroll
        for (int bj = 0; bj < 4; ++bj)
#pragma unroll
            for (int eb = 0; eb < 4; ++eb) { const bf16x8 vf = *(LAS bf16x8*)(vb + eb * 32 * VROW + voff + bj * 32);
                o[0][eb] = MFMA32(P[0][bj], vf, o[0][eb]); o[1][eb] = MFMA32(P[1][bj], vf, o[1][eb]); }
        if (t + 1 < NT) ATT_WRITEV(cur ^ 1);
        __syncthreads();
    }
#undef ATT_LOADK
#undef ATT_LOADV
#undef ATT_WRITEK
#undef ATT_WRITEV
    const float l0 = lsum[0] + __shfl_xor(lsum[0], 32), l1 = lsum[1] + __shfl_xor(lsum[1], 32);
    if (hi == 0) { wsf[r32] = 1.f / l0; wsf[32 + r32] = lam / l1; }
    float ss[16];
#pragma unroll
    for (int r = 0; r < 16; ++r) { const float a = wsf[crow(r, hi)], b = wsf[32 + crow(r, hi)]; float q = 0.f;
#pragma unroll
        for (int eb = 0; eb < 4; ++eb) { const float v = o[0][eb][r] * a - o[1][eb][r] * b; o[0][eb][r] = v; q += v * v; }
        ss[r] = q; }
#pragma unroll
    for (int r = 0; r < 16; ++r) {
#pragma unroll
        for (int sft = 1; sft < 32; sft <<= 1) ss[r] += __shfl_xor(ss[r], sft);
        ss[r] = __builtin_amdgcn_rsqf(ss[r] * (1.f / 128.f) + EPS) * (1.f - LAM_INIT);
    }
    float gsub[4];
#pragma unroll
    for (int eb = 0; eb < 4; ++eb) gsub[eb] = subg[eb * 32 + r32];
#pragma unroll
    for (int r = 0; r < 16; ++r) { const size_t off = (rowq0 + crow(r, hi)) * 1024 + h * 128 + r32;
#pragma unroll
        for (int eb = 0; eb < 4; ++eb) { const float z = __uint_as_float((unsigned)ZB[off + eb * 32] << 16);
            const float y = o[0][eb][r] * ss[r] * gsub[eb] * z; YB[off + eb * 32] = (bf16_t)(pkbf(y, 0.f) & 0xffffu); } }
}
}

namespace gm {
constexpr int TROW = 272;
__device__ __forceinline__ void unit(LAS unsigned char* lds, const bf16_t* __restrict__ V, const bf16_t* __restrict__ U, const bf16_t* __restrict__ SZA, bf16_t* __restrict__ YA,
                                     const float* __restrict__ lnsum, const float* __restrict__ lng, const float* __restrict__ lnb, const bf16_t* __restrict__ wsbf,
                                     const float* __restrict__ bs, int c, int h) {
    int tid_l = threadIdx.x; asm volatile("" : "+v"(tid_l));
    const int tid = tid_l, lane = tid & 63, wid = __builtin_amdgcn_readfirstlane(tid >> 6), r32 = lane & 31, hi = lane >> 5;
    const size_t row0 = (size_t)c * 128;
    {
        const int tok = tid & 127;
        const float sm = lnsum[(row0 + tok) * 2], sq = lnsum[(row0 + tok) * 2 + 1];
        const float mean = sm * (1.f / 1024.f), var = sq * (1.f / 1024.f) - mean * mean, rstd = __builtin_amdgcn_rsqf(fmaxf(var, 0.f) + EPS);
#pragma unroll
        for (int i = 0; i < 4; ++i) { const int dch = (tid >> 7) + 4 * i;
            const u32x4 raw = *(const u32x4*)(V + (row0 + tok) * 1024 + h * 128 + dch * 8);
            const unsigned w[4] = {raw.x, raw.y, raw.z, raw.w};
#pragma unroll
            for (int k = 0; k < 8; ++k) { const int d = dch * 8 + k; const float val = (k & 1) ? bfhi(w[k >> 1]) : bflo(w[k >> 1]);
                const float vn = (val - mean) * rstd * lng[h * 128 + d] + lnb[h * 128 + d];
                *(LAS bf16_t*)(lds + d * TROW + tok * 2) = (bf16_t)(pkbf(vn, 0.f) & 0xffffu); } }
    }
    __syncthreads();
    const int db = wid >> 1, ib0 = 2 * (wid & 1);
    f32x16 acc[2];
#pragma unroll
    for (int ii = 0; ii < 2; ++ii)
#pragma unroll
        for (int r = 0; r < 16; ++r) acc[ii][r] = 0.f;
#pragma unroll
    for (int ks = 0; ks < 8; ++ks) { const bf16x8 a = *(LAS bf16x8*)(lds + (32 * db + r32) * TROW + (16 * ks + 8 * hi) * 2);
#pragma unroll
        for (int ii = 0; ii < 2; ++ii) { const bf16x8 b = *(const bf16x8*)(wsbf + ((size_t)(h * 128 + 32 * (ib0 + ii) + r32) * 128 + 16 * ks + 8 * hi)); acc[ii] = MFMA32(a, b, acc[ii]); } }
#pragma unroll
    for (int ii = 0; ii < 2; ++ii) { const int i = 32 * (ib0 + ii) + r32; const float bsv = bs[h * 128 + i];
#pragma unroll
        for (int g4 = 0; g4 < 4; ++g4) { const size_t off = (row0 + i) * 1024 + h * 128 + 32 * db + 8 * g4 + 4 * hi;
            const u32x2 uu = *(const u32x2*)(U + off), zz = *(const u32x2*)(SZA + off);
            const float y0 = bflo(uu.x) * (acc[ii][4 * g4] + bsv) * bflo(zz.x), y1 = bfhi(uu.x) * (acc[ii][4 * g4 + 1] + bsv) * bfhi(zz.x);
            const float y2 = bflo(uu.y) * (acc[ii][4 * g4 + 2] + bsv) * bflo(zz.y), y3 = bfhi(uu.y) * (acc[ii][4 * g4 + 3] + bsv) * bfhi(zz.y);
            u32x2 w; w.x = pkbf(y0, y1); w.y = pkbf(y2, y3); *(u32x2*)(YA + off) = w; } }
    __syncthreads();
}
}

__device__ __forceinline__ int main_src_col(int n) {
    const int seg8 = n >> 10; int c = n & 1023; const int sseg = seg8 < 5 ? seg8 : seg8 + 1;
    if (seg8 == SEG_Q || seg8 == SEG_K) { const int p = c & 63; c = (c & ~63) | ((p >> 1) + 32 * (p & 1)); }
    return sseg * 1024 + c;
}
__device__ __forceinline__ void transpose_item(const float* __restrict__ W, int ldw, int mode, int coff, const float* __restrict__ gk, bf16_t* __restrict__ WT, int K, int nblk,
                                               LAS float* scr, int item, int lane) {
    const int kb = item / nblk, nb = item % nblk, k0 = 64 * kb, n0 = 32 * nb;
    const int nn = n0 + (lane & 31), srcc = mode ? main_src_col(nn) : coff + nn;
#pragma unroll 8
    for (int i = 0; i < 32; ++i) { const int kk = 2 * i + (lane >> 5); float w = W[(size_t)(k0 + kk) * ldw + srcc]; if (gk) w *= gk[k0 + kk]; scr[kk * 33 + (lane & 31)] = w; }
    asm volatile("s_waitcnt lgkmcnt(0)" ::: "memory");
    const int c = lane & 7;
#pragma unroll
    for (int j = 0; j < 4; ++j) { const int n = (lane >> 3) + 8 * j; const LAS float* s = scr + (8 * c) * 33 + n;
        u32x4 o; o.x = pkbf(s[0 * 33], s[1 * 33]); o.y = pkbf(s[2 * 33], s[3 * 33]); o.z = pkbf(s[4 * 33], s[5 * 33]); o.w = pkbf(s[6 * 33], s[7 * 33]);
        *(u32x4*)(WT + (size_t)(n0 + n) * K + k0 + 8 * c) = o; }
    asm volatile("s_waitcnt lgkmcnt(0)" ::: "memory");
}

struct Args { const float* in[16]; float* out; unsigned char* ws; int ph_lo, ph_hi; };
enum { IN_X = 0, IN_LNPRE, IN_WIN, IN_GMLNG, IN_GMLNB, IN_GMWS, IN_GMBS, IN_LQ1, IN_LK1, IN_LQ2, IN_LK2, IN_SUBG, IN_WA, IN_WB, IN_WOUT, IN_LNPOST };
constexpr int N_PHASES = 2 + 4 * NGROUP;

__global__ void __launch_bounds__(512, 2) fwd_kernel(Args a) {
    extern __shared__ __attribute__((aligned(16))) unsigned char lds_raw[];
    LAS unsigned char* lds = (LAS unsigned char*)lds_raw;
    const int tid = threadIdx.x, lane = tid & 63, wid = __builtin_amdgcn_readfirstlane(tid >> 6);
    const int G = gridDim.x, bx = blockIdx.x;
    const int vcu = (G % 8 == 0) ? (bx % 8) * (G / 8) + bx / 8 : bx;
    unsigned char* ws = a.ws;
    bf16_t* Wmain = (bf16_t*)(ws + WS_WMAIN); bf16_t* Wvv = (bf16_t*)(ws + WS_WVV); bf16_t* Wa = (bf16_t*)(ws + WS_WA); bf16_t* Wb = (bf16_t*)(ws + WS_WB); bf16_t* Wout = (bf16_t*)(ws + WS_WOUT);
    bf16_t* gmws = (bf16_t*)(ws + WS_GMWS); float* rope = (float*)(ws + WS_ROPE); float* lnsum = (float*)(ws + WS_LNSUM); float* rowss = (float*)(ws + WS_ROWSS);
    bf16_t* XN = (bf16_t*)(ws + WS_XN); bf16_t* PROJ = (bf16_t*)(ws + WS_PROJ); bf16_t* VT = (bf16_t*)(ws + WS_VT); bf16_t* YA = (bf16_t*)(ws + WS_YA); bf16_t* YB = (bf16_t*)(ws + WS_YB);
    float* TMP = (float*)(ws + WS_TMP); bf16_t* MERGED = (bf16_t*)(ws + WS_MERGED);
    const int lo = a.ph_lo, hi_ph = a.ph_hi;
#define IN(k) (lo <= (k) && (k) < hi_ph)
#define SYNC(k) do { if (MK_N_LAUNCHES == 1) { if ((k) + 1 < hi_ph) cg::this_grid().sync(); } } while (0)
    const int gw = vcu * 8 + wid, NGW = G * 8;

    if (IN(0)) {
        LAS float* scr = (LAS float*)(lds + wid * 16384);
        constexpr int I_MAIN = 16 * (NMAIN / 32), I_SQ = 16 * 32;
        for (int it = gw; it < I_MAIN + 4 * I_SQ; it += NGW) {
            int r = it;
            if (r < I_MAIN) { transpose_item(a.in[IN_WIN], 9216, 1, 0, a.in[IN_LNPRE], Wmain, 1024, NMAIN / 32, scr, r, lane); continue; } r -= I_MAIN;
            if (r < I_SQ) { transpose_item(a.in[IN_WIN], 9216, 0, 5120, a.in[IN_LNPRE], Wvv, 1024, 32, scr, r, lane); continue; } r -= I_SQ;
            if (r < I_SQ) { transpose_item(a.in[IN_WA], 1024, 0, 0, nullptr, Wa, 1024, 32, scr, r, lane); continue; } r -= I_SQ;
            if (r < I_SQ) { transpose_item(a.in[IN_WB], 1024, 0, 0, nullptr, Wb, 1024, 32, scr, r, lane); continue; } r -= I_SQ;
            transpose_item(a.in[IN_WOUT], 1024, 0, 0, nullptr, Wout, 1024, 32, scr, r, lane);
        }
        const float* x = a.in[IN_X];
        for (int m = gw; m < MTOT; m += NGW) {
            const f32x4* xr = (const f32x4*)(x + (size_t)m * 1024) + lane; f32x4 v[4]; float s = 0.f;
#pragma unroll
            for (int j = 0; j < 4; ++j) { v[j] = xr[64 * j]; s += (v[j][0] * v[j][0] + v[j][1] * v[j][1]) + (v[j][2] * v[j][2] + v[j][3] * v[j][3]); }
            const float rstd = 1.f / sqrtf(wave_sum(s) * (1.f / 1024.f) + EPS);
            u32x2* o8 = (u32x2*)(XN + (size_t)m * 1024) + lane;
#pragma unroll
            for (int j = 0; j < 4; ++j) { u32x2 w; w.x = pkbf(v[j][0] * rstd, v[j][1] * rstd); w.y = pkbf(v[j][2] * rstd, v[j][3] * rstd); o8[64 * j] = w; }
        }
        const int gt = vcu * 512 + tid, NGT = G * 512;
        for (int i = gt; i < SEQ * 32; i += NGT) { const int pos = i >> 5, fi = i & 31;
            const double inv = exp(-(double)fi * (9.210340371976184 / 32.0)); const double ang = (double)pos * inv;
            rope[2 * i] = (float)cos(ang); rope[2 * i + 1] = (float)sin(ang); }
        for (int i = gt; i < MTOT * 2; i += NGT) lnsum[i] = 0.f;
        for (int i = gt; i < MTOT; i += NGT) rowss[i] = 0.f;
        const float* gws = a.in[IN_GMWS];
        for (int i = gt; i < 8 * 128 * 128 / 2; i += NGT) ((unsigned*)gmws)[i] = pkbf(gws[2 * i], gws[2 * i + 1]);
        SYNC(0);
    }

#pragma unroll 1
    for (int g = 0; g < NGROUP; ++g) {
        const bf16_t* XNg = XN + (size_t)g * MG * 1024;
        if (IN(1 + 4 * g)) {
            { pg8::Gemm gm_{XNg, Wmain, MG, NMAIN, 1024}; pg8::StaticOrder S; S.init(MG, NMAIN, G, bx);
              EpiProj E{PROJ, rope, lnsum + (size_t)g * MG * 2};
              pg8::gemm_phase<EpiProj, pg8::StaticOrder, true, true>(lds, gm_, S, E); }
            { pg8::Gemm gm_{Wvv, XNg, 1024, MG, 1024}; pg8::StaticOrder S; S.init(1024, MG, G, bx);
              EpiPlain E{VT, MG};
              pg8::gemm_phase<EpiPlain, pg8::StaticOrder, false, true>(lds, gm_, S, E); }
            SYNC(1 + 4 * g);
        }
        if (IN(2 + 4 * g)) {
            int ln = threadIdx.x & 63; asm volatile("" : "+v"(ln));
            const float t1 = wave_sum(a.in[IN_LQ1][ln] * a.in[IN_LK1][ln]), t2 = wave_sum(a.in[IN_LQ2][ln] * a.in[IN_LK2][ln]);
            const float lam = __expf(t1) - __expf(t2) + LAM_INIT;
            for (int ui = vcu; ui < BPG * 8 * 8; ui += G) { const int bh = ui >> 3, qb = ui & 7;
                att::attn_unit(lds, PROJ + SEG_Q * SEG_ELEMS, PROJ + SEG_K * SEG_ELEMS, VT, PROJ + SEG_ZB * SEG_ELEMS, YB, a.in[IN_SUBG], lam, bh >> 3, bh & 7, qb); }
            __syncthreads();
            for (int ui = vcu; ui < (MG / 128) * 8; ui += G) { const int c = ui >> 3, h = ui & 7;
                gm::unit(lds, PROJ + SEG_V * SEG_ELEMS, PROJ + SEG_U * SEG_ELEMS, PROJ + SEG_ZA * SEG_ELEMS, YA, lnsum + (size_t)g * MG * 2, a.in[IN_GMLNG], a.in[IN_GMLNB], gmws, a.in[IN_GMBS], c, h); }
            SYNC(2 + 4 * g);
        }
        if (IN(3 + 4 * g)) {
            { pg8::Gemm gm_{YA, Wa, MG, 1024, 1024}; pg8::StaticOrder S; S.init(MG, 1024, G, bx);
              EpiGateA E{PROJ + SEG_GA * SEG_ELEMS, TMP};
              pg8::gemm_phase<EpiGateA, pg8::StaticOrder, false, true>(lds, gm_, S, E); }
            { pg8::Gemm gm_{YB, Wb, MG, 1024, 1024}; pg8::StaticOrder S; S.init(MG, 1024, G, bx);
              EpiGateB E{PROJ + SEG_GB * SEG_ELEMS, TMP, MERGED};
              pg8::gemm_phase<EpiGateB, pg8::StaticOrder, false, true>(lds, gm_, S, E); }
            SYNC(3 + 4 * g);
        }
        if (IN(4 + 4 * g)) {
            pg8::Gemm gm_{MERGED, Wout, MG, 1024, 1024}; pg8::StaticOrder S; S.init(MG, 1024, G, bx);
            EpiOut E{a.out + (size_t)g * MG * 1024, rowss + (size_t)g * MG};
            pg8::gemm_phase<EpiOut, pg8::StaticOrder, false, true>(lds, gm_, S, E);
            if (g == NGROUP - 1) SYNC(4 + 4 * g);
        }
    }
    if (IN(N_PHASES - 1)) {
        const float* x = a.in[IN_X]; const float* gp = a.in[IN_LNPOST];
        f32x4 gv[4];
#pragma unroll
        for (int j = 0; j < 4; ++j) gv[j] = ((const f32x4*)gp)[64 * j + lane];
        for (int m = gw; m < MTOT; m += NGW) {
            const float rs = 1.f / sqrtf(rowss[m] * (1.f / 1024.f) + EPS);
            const f32x4* xr = (const f32x4*)(x + (size_t)m * 1024) + lane; f32x4* orow = (f32x4*)(a.out + (size_t)m * 1024) + lane;
#pragma unroll
            for (int j = 0; j < 4; ++j) { const f32x4 ov = orow[64 * j]; orow[64 * j] = xr[64 * j] + ov * rs * gv[j]; }
        }
    }
#undef IN
#undef SYNC
}

extern "C" void kernel_launch(void* const* d_in, const int* in_sizes, int n_in, void* d_out, int out_size, void* d_ws, size_t ws_size, hipStream_t stream) {
    static int grid = 0;
    if (grid == 0) {
        if (n_in != 16 || in_sizes[0] != MTOT * DMOD || out_size != MTOT * DMOD || ws_size < WS_END) { fprintf(stderr, "kernel_launch: unexpected shapes / workspace (n_in %d, ws %zu)\n", n_in, ws_size); grid = -1; return; }
        int dev = 0, cus = 0, per_cu = 0;
        hipGetDevice(&dev); hipDeviceGetAttribute(&cus, hipDeviceAttributeMultiprocessorCount, dev);
        if (hipFuncSetAttribute((const void*)fwd_kernel, hipFuncAttributeMaxDynamicSharedMemorySize, LDS_BYTES) != hipSuccess) { fprintf(stderr, "kernel_launch: hipFuncSetAttribute failed\n"); grid = -1; return; }
        if (hipOccupancyMaxActiveBlocksPerMultiprocessor(&per_cu, (const void*)fwd_kernel, 512, LDS_BYTES) != hipSuccess || per_cu < 1) { fprintf(stderr, "kernel_launch: occupancy query gave %d\n", per_cu); per_cu = 1; }
        (void)hipGetLastError();
        grid = cus * per_cu;
    }
    if (grid < 0) return;
    Args a{};
    for (int i = 0; i < 16; ++i) a.in[i] = (const float*)d_in[i];
    a.out = (float*)d_out; a.ws = (unsigned char*)d_ws;
#if MK_N_LAUNCHES == 1
    a.ph_lo = 0; a.ph_hi = N_PHASES;
    void* args[] = {&a};
    hipError_t e = hipLaunchCooperativeKernel((const void*)fwd_kernel, dim3(grid), dim3(512), args, LDS_BYTES, stream);
    if (e != hipSuccess) fprintf(stderr, "kernel_launch: cooperative launch failed: %s (grid %d)\n", hipGetErrorString(e), grid);
#else
    for (int p = 0; p < N_PHASES; ++p) { a.ph_lo = p; a.ph_hi = p + 1; hipLaunchKernelGGL(fwd_kernel, dim3(grid), dim3(512), LDS_BYTES, stream, a); }
#endif
}
```

```cpp
#include <hip/hip_runtime.h>
#include <hip/hip_cooperative_groups.h>
#include <cstdio>
#include <cstdint>
namespace cg = cooperative_groups;
namespace pg8 {
#define PG8_LAS __attribute__((address_space(3)))
typedef unsigned short bf16_t;
typedef short bf16x8 __attribute__((ext_vector_type(8)));
typedef float f32x4 __attribute__((ext_vector_type(4)));
typedef unsigned u32x4 __attribute__((ext_vector_type(4)));
constexpr int BM = 256, BK = 64, HALF = 128, HTB = HALF * BK * 2  , STAGE_BYTES = 8 * HTB, NXCD = 8, WGM = 8;

__host__ __device__ __forceinline__ int lds_byte(int r, int c) { const int st = (r >> 4) * 2 + (c >> 5), rr = r & 15, cc = c & 31, ob = rr * 64 + cc * 2; return st * 1024 + (ob ^ (((ob >> 9) & 1) << 5)); }
__host__ __device__ __forceinline__ void stage_rc(int b, int& R, int& C) { const int st = b / 1024, sb = b % 1024, swz = sb ^ (((sb >> 9) & 1) << 5); R = (st >> 1) * 16 + swz / 64; C = (st & 1) * 32 + (swz % 64) / 2; }
__host__ __device__ __forceinline__ int perm32(int rho) { const int n = rho >> 4, i = rho & 15; return 8 * (i >> 2) + 4 * n + (i & 3); }

struct Unit { int pm, pn; };
struct Gemm { const bf16_t* A; const bf16_t* Bt; int M, N, K; };

struct StaticOrder {
    int nM, nN, nwg, G, c;
    __host__ __device__ void init(int M, int N, int G_, int c_) { nM = M / BM; nN = N / BM; nwg = nM * nN; G = G_; c = c_; }
    __host__ __device__ bool next(int i, Unit& u) const {
        const long L = (long)i * G + c; if (L >= nwg) return false;
        int wgid = (int)L; { const int q = nwg / NXCD, r = nwg % NXCD, xcd = wgid % NXCD, off = wgid / NXCD; wgid = (xcd < r ? xcd * (q + 1) : r * (q + 1) + (xcd - r) * q) + off; }
        const int nig = WGM * nN, gid = wgid / nig, fm = gid * WGM, gsz = (nM - fm) < WGM ? (nM - fm) : WGM;
        u.pm = fm + ((wgid % nig) % gsz); u.pn = (wgid % nig) / gsz; return true;
    }
    __device__ __forceinline__ void a_ready(const Unit&) const {}
    __device__ __forceinline__ void done(const Unit&) const {}
};

template <class Epi, class Sched, bool ALIGN_EPI = false, bool SP2 = false>
__device__ __forceinline__ void gemm_phase(PG8_LAS unsigned char* lds, const Gemm g, const Sched& S, const Epi& E) {
    int tid_l = threadIdx.x; asm volatile("" : "+v"(tid_l));
    const int tid = tid_l, wid = __builtin_amdgcn_readfirstlane(tid >> 6), lane = tid & 63, wr = wid >> 2, wc = wid & 3, fr = lane & 15, fq = lane >> 4;
    const int K = g.K, nt = K / BK;
    unsigned voffA[2], voffB[2];
#pragma unroll
    for (int i = 0; i < 2; ++i) { int R, C; stage_rc(tid * 16 + i * 8192, R, C); const int Rb = Epi::PERM ? ((R & ~31) + perm32(R & 31)) : R;
        voffA[i] = (unsigned)(R * K + C) * 2u; voffB[i] = (unsigned)(Rb * K + C) * 2u; }
    const size_t kstep = (size_t)(BK * 2);
    const size_t hstep = (size_t)HALF * K * 2;
    const size_t tstep = 2 * hstep;
    const unsigned ldsw = (unsigned)wid * 1024u;
    const int aoff = lds_byte(wr * 64 + fr, fq * 8), boff = lds_byte(wc * 32 + fr, fq * 8);
#define PG8_SA(b, h) (((b) * 2 + (h)) * HTB)
#define PG8_SB(b, h) ((4 + (b) * 2 + (h)) * HTB)
#define PG8_STAGE(bufoff, gbase, voff) do { _Pragma("unroll") for (int _i = 0; _i < 2; ++_i) \
        __builtin_amdgcn_global_load_lds((const unsigned*)((const char*)(gbase) + (voff)[_i]), (PG8_LAS unsigned*)(lds + (bufoff) + ldsw + _i * 8192), 16, 0, 0); } while (0)
#define PG8_LDA(dst, b, h) do { _Pragma("unroll") for (int m = 0; m < 4; ++m) _Pragma("unroll") for (int k = 0; k < 2; ++k) dst[m][k] = *(const PG8_LAS bf16x8*)(lds + PG8_SA(b, h) + aoff + m * 2048 + k * 1024); } while (0)
#define PG8_LDB(dst, b, h) do { _Pragma("unroll") for (int n = 0; n < 2; ++n) _Pragma("unroll") for (int k = 0; k < 2; ++k) dst[n][k] = *(const PG8_LAS bf16x8*)(lds + PG8_SB(b, h) + boff + n * 2048 + k * 1024); } while (0)
#define PG8_MMA(ai, bj, At, Bt) do { __builtin_amdgcn_s_setprio(1); _Pragma("unroll") for (int m = 0; m < 4; ++m) _Pragma("unroll") for (int n = 0; n < 2; ++n) _Pragma("unroll") for (int k = 0; k < 2; ++k) \
        acc[ai][bj][m][n] = __builtin_amdgcn_mfma_f32_16x16x32_bf16(Bt[n][k], At[m][k], acc[ai][bj][m][n], 0, 0, 0); __builtin_amdgcn_s_setprio(0); } while (0)
#define PG8_WAIT_V(n) asm volatile("s_waitcnt vmcnt(" #n ")" ::: "memory")
#define PG8_WAIT_L(n) asm volatile("s_waitcnt lgkmcnt(" #n ")" ::: "memory")
#define PG8_BAR __builtin_amdgcn_s_barrier()
#define PG8_SCHED __builtin_amdgcn_sched_barrier(0)
    Unit cur, nxt; int ui = 0;
    if (!S.next(0, cur)) return;
    f32x4 acc[2][2][4][2];
#pragma unroll
    for (int a = 0; a < 2; ++a)
#pragma unroll
        for (int b = 0; b < 2; ++b)
#pragma unroll
            for (int m = 0; m < 4; ++m)
#pragma unroll
                for (int n = 0; n < 2; ++n) acc[a][b][m][n] = (f32x4){0.f, 0.f, 0.f, 0.f};
    bf16x8 At[4][2], B0[2][2], B1[2][2];
    const char* cA = (const char*)g.A + (size_t)cur.pm * tstep; const char* cB = (const char*)g.Bt + (size_t)cur.pn * tstep;
    S.a_ready(cur);
    if constexpr (SP2) {
        PG8_STAGE(PG8_SB(0, 0), cB, voffB); PG8_STAGE(PG8_SB(0, 1), cB + hstep, voffB); PG8_STAGE(PG8_SA(0, 0), cA, voffA); PG8_STAGE(PG8_SA(0, 1), cA + hstep, voffA);
        if (wr == 1) PG8_BAR;
        PG8_WAIT_V(2); PG8_BAR;
        PG8_STAGE(PG8_SB(1, 0), cB + kstep, voffB); PG8_STAGE(PG8_SA(1, 0), cA + kstep, voffA); PG8_STAGE(PG8_SB(1, 1), cB + hstep + kstep, voffB);
        PG8_WAIT_V(6); PG8_BAR;
    } else {
        PG8_STAGE(PG8_SB(0, 0), cB, voffB); PG8_STAGE(PG8_SA(0, 0), cA, voffA); PG8_STAGE(PG8_SB(0, 1), cB + hstep, voffB); PG8_STAGE(PG8_SA(0, 1), cA + hstep, voffA);
        if (wr == 1) PG8_BAR;
        PG8_WAIT_V(4); PG8_BAR;
        PG8_STAGE(PG8_SB(1, 0), cB + kstep, voffB); PG8_STAGE(PG8_SA(1, 0), cA + kstep, voffA); PG8_STAGE(PG8_SB(1, 1), cB + hstep + kstep, voffB);
        PG8_WAIT_V(6); PG8_BAR;
    }
    for (;;) {
        const bool has_next = S.next(ui + 1, nxt);
        const char* nA = has_next ? (const char*)g.A + (size_t)nxt.pm * tstep : cA; const char* nB = has_next ? (const char*)g.Bt + (size_t)nxt.pn * tstep : cB;
        for (int t = 0; t < nt; t += 2) {
            const bool last = (t == nt - 2);
            const char* a1 = cA + (size_t)(t + 1) * kstep;
            const char* a2 = last ? nA : cA + (size_t)(t + 2) * kstep; const char* b2 = last ? nB : cB + (size_t)(t + 2) * kstep;
            const char* a3 = a2 + kstep; const char* b3 = b2 + kstep;
            if (last && has_next) S.a_ready(nxt);
            if constexpr (SP2) {
            PG8_LDB(B0, 0, 0); PG8_LDB(B1, 0, 1); PG8_SCHED; PG8_LDA(At, 0, 0); PG8_STAGE(PG8_SA(1, 1), a1 + hstep, voffA);
            PG8_WAIT_V(8); PG8_WAIT_L(0); PG8_BAR; PG8_MMA(0, 0, At, B0); PG8_MMA(0, 1, At, B1); PG8_BAR; PG8_SCHED;
            PG8_LDA(At, 0, 1); PG8_STAGE(PG8_SB(0, 0), b2, voffB); PG8_STAGE(PG8_SB(0, 1), b2 + hstep, voffB); PG8_STAGE(PG8_SA(0, 0), a2, voffA);
            PG8_WAIT_V(8); PG8_WAIT_L(0); PG8_BAR; PG8_MMA(1, 0, At, B0); PG8_MMA(1, 1, At, B1); PG8_BAR; PG8_SCHED;
            PG8_LDB(B0, 1, 0); PG8_LDB(B1, 1, 1); PG8_SCHED; PG8_LDA(At, 1, 0); PG8_STAGE(PG8_SA(0, 1), a2 + hstep, voffA);
            PG8_WAIT_V(8); PG8_WAIT_L(0); PG8_BAR; PG8_MMA(0, 0, At, B0); PG8_MMA(0, 1, At, B1); PG8_BAR; PG8_SCHED;
            PG8_LDA(At, 1, 1); PG8_STAGE(PG8_SB(1, 0), b3, voffB); PG8_STAGE(PG8_SB(1, 1), b3 + hstep, voffB); PG8_STAGE(PG8_SA(1, 0), a3, voffA);
            PG8_WAIT_V(8); PG8_WAIT_L(0); PG8_BAR; PG8_MMA(1, 0, At, B0); PG8_MMA(1, 1, At, B1); PG8_BAR; PG8_SCHED;
            } else {
            PG8_LDB(B0, 0, 0); PG8_SCHED; PG8_LDA(At, 0, 0); PG8_STAGE(PG8_SA(1, 1), a1 + hstep, voffA);
            PG8_WAIT_L(8); PG8_BAR; PG8_WAIT_L(0); PG8_MMA(0, 0, At, B0); PG8_BAR; PG8_SCHED;
            PG8_LDB(B1, 0, 1); PG8_STAGE(PG8_SB(0, 0), b2, voffB);
            PG8_BAR; PG8_WAIT_L(0); PG8_MMA(0, 1, At, B1); PG8_BAR;
            PG8_LDA(At, 0, 1); PG8_STAGE(PG8_SA(0, 0), a2, voffA);
            PG8_BAR; PG8_WAIT_L(0); PG8_MMA(1, 0, At, B0); PG8_BAR; PG8_SCHED;
            PG8_STAGE(PG8_SB(0, 1), b2 + hstep, voffB);
            PG8_WAIT_V(6); PG8_BAR; PG8_MMA(1, 1, At, B1); PG8_BAR;
            PG8_LDB(B0, 1, 0); PG8_SCHED; PG8_LDA(At, 1, 0); PG8_STAGE(PG8_SA(0, 1), a2 + hstep, voffA);
            PG8_WAIT_L(8); PG8_BAR; PG8_WAIT_L(0); PG8_MMA(0, 0, At, B0); PG8_BAR; PG8_SCHED;
            PG8_LDB(B1, 1, 1); PG8_STAGE(PG8_SB(1, 0), b3, voffB);
            PG8_BAR; PG8_WAIT_L(0); PG8_MMA(0, 1, At, B1); PG8_BAR;
            PG8_LDA(At, 1, 1); PG8_STAGE(PG8_SA(1, 0), a3, voffA);
            PG8_BAR; PG8_WAIT_L(0); PG8_MMA(1, 0, At, B0); PG8_BAR; PG8_SCHED;
            PG8_STAGE(PG8_SB(1, 1), b3 + hstep, voffB);
            PG8_WAIT_V(6); PG8_BAR; PG8_MMA(1, 1, At, B1); PG8_BAR;
            }
        }
        if constexpr (ALIGN_EPI) { if (wr == 0) PG8_BAR; }
        if constexpr (!Epi::AFTER_DRAIN) { E(acc, cur, wr, wc, fr, fq); S.done(cur); }
        if (!has_next) break;
#pragma unroll
        for (int a = 0; a < 2; ++a)
#pragma unroll
            for (int b = 0; b < 2; ++b)
#pragma unroll
                for (int m = 0; m < 4; ++m)
#pragma unroll
                    for (int n = 0; n < 2; ++n) acc[a][b][m][n] = (f32x4){0.f, 0.f, 0.f, 0.f};
        cur = nxt; cA = nA; cB = nB; ++ui;
        if constexpr (ALIGN_EPI) { if (wr == 1) PG8_BAR; }
    }
    PG8_WAIT_V(0);
    if constexpr (!ALIGN_EPI) { if (wr == 0) PG8_BAR; }
    PG8_BAR;
    if constexpr (Epi::AFTER_DRAIN) { E.fused(acc, cur, wr, wc, fr, fq, lds, wid, lane); S.done(cur); }
#undef PG8_SA
#undef PG8_SB
#undef PG8_STAGE
#undef PG8_LDA
#undef PG8_LDB
#undef PG8_MMA
#undef PG8_WAIT_V
#undef PG8_WAIT_L
#undef PG8_BAR
#undef PG8_SCHED
}
}
#ifndef MK_N_LAUNCHES
#define MK_N_LAUNCHES 1
#endif
#define LAS __attribute__((address_space(3)))
using pg8::bf16_t; using pg8::bf16x8; using pg8::f32x4; using pg8::u32x4;
typedef float f32x16 __attribute__((ext_vector_type(16)));
typedef unsigned u32x2 __attribute__((ext_vector_type(2)));

constexpr int DMOD = 1024, SEQ = 2048, NB = 32, MTOT = NB * SEQ, BPG = 8, MG = BPG * SEQ, NGROUP = NB / BPG;
constexpr int NMAIN = 8192;
constexpr float EPS = 1e-6f;
constexpr float C2 = 0.125f * 1.4426950408889634f;
constexpr float LAM_INIT = 0.2f;
constexpr size_t MiB = 1u << 20;
constexpr size_t WS_WMAIN = 1 * MiB, WS_WVV = 17 * MiB, WS_WA = 19 * MiB, WS_WB = 21 * MiB, WS_WOUT = 23 * MiB, WS_GMWS = 25 * MiB,
                 WS_ROPE = 25 * MiB + 256 * 1024, WS_LNSUM = 26 * MiB, WS_ROWSS = 26 * MiB + 512 * 1024, WS_XN = 32 * MiB,
                 WS_PROJ = 160 * MiB, SEG_BYTES = 32 * MiB, WS_VT = 416 * MiB, WS_YA = 448 * MiB, WS_YB = 480 * MiB,
                 WS_TMP = 512 * MiB, WS_MERGED = 576 * MiB, WS_END = 608 * MiB;
constexpr size_t SEG_ELEMS = (size_t)MG * 1024;
enum { SEG_U = 0, SEG_V = 1, SEG_ZA = 2, SEG_Q = 3, SEG_K = 4, SEG_ZB = 5, SEG_GA = 6, SEG_GB = 7 };
constexpr int LDS_BYTES = 147456;

__device__ __forceinline__ unsigned pkbf(float lo, float hi) {
    typedef float f2 __attribute__((ext_vector_type(2))); typedef __bf16 b2 __attribute__((ext_vector_type(2)));
    f2 v = {lo, hi}; b2 b = __builtin_convertvector(v, b2); return __builtin_bit_cast(unsigned, b);
}
__device__ __forceinline__ float bflo(unsigned w) { return __uint_as_float(w << 16); }
__device__ __forceinline__ float bfhi(unsigned w) { return __uint_as_float(w & 0xffff0000u); }
__device__ __forceinline__ u32x4 pack8(f32x4 a, f32x4 b) { u32x4 w; w.x = pkbf(a[0], a[1]); w.y = pkbf(a[2], a[3]); w.z = pkbf(b[0], b[1]); w.w = pkbf(b[2], b[3]); return w; }
__device__ __forceinline__ float sigm(float x) { return __builtin_amdgcn_rcpf(1.f + __expf(-x)); }
__device__ __forceinline__ float wave_sum(float v) {
#pragma unroll
    for (int o = 1; o < 64; o <<= 1) v += __shfl_xor(v, o);
    return v;
}

struct EpiProj {
    static constexpr bool PERM = true, AFTER_DRAIN = false;
    bf16_t* base; const float* rope; float* lnsum;
    __device__ __forceinline__ void operator()(const f32x4 (&acc)[2][2][4][2], const pg8::Unit& u, int wr, int wc, int fr, int fq) const {
        const int seg = u.pn >> 2;
        bf16_t* O = base + (size_t)seg * SEG_ELEMS;
        const int col0 = (u.pn & 3) * 256 + wc * 32 + 8 * fq;
        const int row0 = u.pm * 256 + wr * 64 + fr;
        const int mode = (seg == SEG_ZA || seg == SEG_ZB) ? 1 : (seg >= SEG_GA ? 2 : ((seg == SEG_Q || seg == SEG_K) ? 3 : (seg == SEG_V ? 4 : 0)));
        const float qs = (seg == SEG_Q) ? C2 : 1.f;
#pragma unroll
        for (int ai = 0; ai < 2; ++ai)
#pragma unroll
            for (int m = 0; m < 4; ++m) {
                const int row = row0 + ai * 128 + m * 16;
                f32x4 cs0 = {1.f, 0.f, 1.f, 0.f}, cs1 = cs0;
                if (mode == 3) { const float* rp = rope + ((size_t)(row & (SEQ - 1)) * 32 + ((wc & 1) * 16 + 4 * fq)) * 2; cs0 = *(const f32x4*)rp; cs1 = *(const f32x4*)(rp + 4); }
                float s = 0.f, q = 0.f;
#pragma unroll
                for (int bj = 0; bj < 2; ++bj) {
                    f32x4 v0 = acc[ai][bj][m][0], v1 = acc[ai][bj][m][1];
                    if (mode == 1) {
#pragma unroll
                        for (int e = 0; e < 4; ++e) { v0[e] = v0[e] * sigm(v0[e]); v1[e] = v1[e] * sigm(v1[e]); }
                    } else if (mode == 2) {
#pragma unroll
                        for (int e = 0; e < 4; ++e) { v0[e] = sigm(v0[e]); v1[e] = sigm(v1[e]); }
                    } else if (mode == 3) {
                        f32x4 a, b;
                        a[0] = (v0[0] * cs0[0] - v0[1] * cs0[1]) * qs; a[1] = (v0[1] * cs0[0] + v0[0] * cs0[1]) * qs;
                        a[2] = (v0[2] * cs0[2] - v0[3] * cs0[3]) * qs; a[3] = (v0[3] * cs0[2] + v0[2] * cs0[3]) * qs;
                        b[0] = (v1[0] * cs1[0] - v1[1] * cs1[1]) * qs; b[1] = (v1[1] * cs1[0] + v1[0] * cs1[1]) * qs;
                        b[2] = (v1[2] * cs1[2] - v1[3] * cs1[3]) * qs; b[3] = (v1[3] * cs1[2] + v1[2] * cs1[3]) * qs;
                        v0 = a; v1 = b;
                    } else if (mode == 4) {
#pragma unroll
                        for (int e = 0; e < 4; ++e) { s += v0[e] + v1[e]; q += v0[e] * v0[e] + v1[e] * v1[e]; }
                    }
                    *(u32x4*)(O + (size_t)row * 1024 + col0 + bj * 128) = pack8(v0, v1);
                }
                if (mode == 4) {
                    s += __shfl_xor(s, 16); s += __shfl_xor(s, 32); q += __shfl_xor(q, 16); q += __shfl_xor(q, 32);
                    if (fq == 0) { unsafeAtomicAdd(lnsum + (size_t)row * 2, s); unsafeAtomicAdd(lnsum + (size_t)row * 2 + 1, q); }
                }
                asm volatile("" ::: "memory");
            }
    }
};
struct EpiPlain {
    static constexpr bool PERM = true, AFTER_DRAIN = false;
    bf16_t* O; int ldc;
    __device__ __forceinline__ void operator()(const f32x4 (&acc)[2][2][4][2], const pg8::Unit& u, int wr, int wc, int fr, int fq) const {
        const int col0 = u.pn * 256 + wc * 32 + 8 * fq, row0 = u.pm * 256 + wr * 64 + fr;
#pragma unroll
        for (int ai = 0; ai < 2; ++ai)
#pragma unroll
            for (int m = 0; m < 4; ++m)
#pragma unroll
                for (int bj = 0; bj < 2; ++bj)
                    *(u32x4*)(O + (size_t)(row0 + ai * 128 + m * 16) * ldc + col0 + bj * 128) = pack8(acc[ai][bj][m][0], acc[ai][bj][m][1]);
    }
};
struct EpiGateA {
    static constexpr bool PERM = true, AFTER_DRAIN = false;
    const bf16_t* G; float* T;
    __device__ __forceinline__ void operator()(const f32x4 (&acc)[2][2][4][2], const pg8::Unit& u, int wr, int wc, int fr, int fq) const {
        const int col0 = u.pn * 256 + wc * 32 + 8 * fq, row0 = u.pm * 256 + wr * 64 + fr;
#pragma unroll
        for (int ai = 0; ai < 2; ++ai)
#pragma unroll
            for (int m = 0; m < 4; ++m)
#pragma unroll
                for (int bj = 0; bj < 2; ++bj) {
                    const size_t off = (size_t)(row0 + ai * 128 + m * 16) * 1024 + col0 + bj * 128;
                    const u32x4 g = *(const u32x4*)(G + off);
                    f32x4 v0 = acc[ai][bj][m][0], v1 = acc[ai][bj][m][1];
                    v0[0] *= bflo(g.x); v0[1] *= bfhi(g.x); v0[2] *= bflo(g.y); v0[3] *= bfhi(g.y);
                    v1[0] *= bflo(g.z); v1[1] *= bfhi(g.z); v1[2] *= bflo(g.w); v1[3] *= bfhi(g.w);
                    *(f32x4*)(T + off) = v0; *(f32x4*)(T + off + 4) = v1;
                    asm volatile("" ::: "memory");
                }
    }
};
struct EpiGateB {
    static constexpr bool PERM = true, AFTER_DRAIN = false;
    const bf16_t* G; const float* T; bf16_t* O;
    __device__ __forceinline__ void operator()(const f32x4 (&acc)[2][2][4][2], const pg8::Unit& u, int wr, int wc, int fr, int fq) const {
        const int col0 = u.pn * 256 + wc * 32 + 8 * fq, row0 = u.pm * 256 + wr * 64 + fr;
#pragma unroll
        for (int ai = 0; ai < 2; ++ai)
#pragma unroll
            for (int m = 0; m < 4; ++m)
#pragma unroll
                for (int bj = 0; bj < 2; ++bj) {
                    const size_t off = (size_t)(row0 + ai * 128 + m * 16) * 1024 + col0 + bj * 128;
                    const u32x4 g = *(const u32x4*)(G + off);
                    f32x4 v0 = acc[ai][bj][m][0], v1 = acc[ai][bj][m][1];
                    const f32x4 t0 = *(const f32x4*)(T + off), t1 = *(const f32x4*)(T + off + 4);
                    v0[0] = t0[0] + v0[0] * bflo(g.x); v0[1] = t0[1] + v0[1] * bfhi(g.x); v0[2] = t0[2] + v0[2] * bflo(g.y); v0[3] = t0[3] + v0[3] * bfhi(g.y);
                    v1[0] = t1[0] + v1[0] * bflo(g.z); v1[1] = t1[1] + v1[1] * bfhi(g.z); v1[2] = t1[2] + v1[2] * bflo(g.w); v1[3] = t1[3] + v1[3] * bfhi(g.w);
                    *(u32x4*)(O + off) = pack8(v0, v1);
                    asm volatile("" ::: "memory");
                }
    }
};
struct EpiOut {
    static constexpr bool PERM = true, AFTER_DRAIN = false;
    float* O; float* rowss;
    __device__ __forceinline__ void operator()(const f32x4 (&acc)[2][2][4][2], const pg8::Unit& u, int wr, int wc, int fr, int fq) const {
        const int col0 = u.pn * 256 + wc * 32 + 8 * fq, row0 = u.pm * 256 + wr * 64 + fr;
#pragma unroll
        for (int ai = 0; ai < 2; ++ai)
#pragma unroll
            for (int m = 0; m < 4; ++m) {
                const int row = row0 + ai * 128 + m * 16; float q = 0.f;
#pragma unroll
                for (int bj = 0; bj < 2; ++bj) {
                    const f32x4 v0 = acc[ai][bj][m][0], v1 = acc[ai][bj][m][1];
                    float* p = O + (size_t)row * 1024 + col0 + bj * 128;
                    *(f32x4*)p = v0; *(f32x4*)(p + 4) = v1;
#pragma unroll
                    for (int e = 0; e < 4; ++e) q += v0[e] * v0[e] + v1[e] * v1[e];
                }
                q += __shfl_xor(q, 16); q += __shfl_xor(q, 32);
                if (fq == 0) unsafeAtomicAdd(rowss + row, q);
            }
    }
};

namespace att {
constexpr int KROW = 272, VROW = 144, KBUF = 64 * KROW, VBUF = 128 * VROW, BUFB = KBUF + VBUF;
constexpr int OFF_Q = 2 * BUFB, QW = 32 * KROW, OFF_WSF = OFF_Q + 8 * QW;
static_assert(OFF_WSF + 8 * 256 <= LDS_BYTES, "attention LDS map");
constexpr float THR = 8.f;
__device__ __forceinline__ int crow(int r, int hi) { return (r & 3) + 8 * (r >> 2) + 4 * hi; }
#define MFMA32(a, b, c) __builtin_amdgcn_mfma_f32_32x32x16_bf16((a), (b), (c), 0, 0, 0)

__device__ __forceinline__ void attn_unit(LAS unsigned char* lds, const bf16_t* __restrict__ Q, const bf16_t* __restrict__ K, const bf16_t* __restrict__ Vt,
                                          const bf16_t* __restrict__ ZB, bf16_t* __restrict__ YB, const float* __restrict__ subg, float lam, int bl, int h, int qb) {
    int tid_l = threadIdx.x; asm volatile("" : "+v"(tid_l));
    const int tid = tid_l, lane = tid & 63, wid = __builtin_amdgcn_readfirstlane(tid >> 6), r32 = lane & 31, hi = lane >> 5;
    const size_t rowq0 = (size_t)bl * SEQ + qb * 256 + wid * 32;
    LAS unsigned char* qlds = lds + OFF_Q + wid * QW;
    LAS float* wsf = (LAS float*)(lds + OFF_WSF + wid * 256);
#pragma unroll
    for (int i = 0; i < 8; ++i) { const int p = lane + 64 * i, row = p >> 4, ch = p & 15;
        const u32x4 v = *(const u32x4*)(Q + (rowq0 + row) * 1024 + h * 128 + ch * 8); *(LAS u32x4*)(qlds + row * KROW + ch * 16) = v; }
    const bf16_t* Kg = K + ((size_t)bl * SEQ) * 1024 + h * 128;
    const bf16_t* Vg = Vt + (size_t)(h * 128) * MG + (size_t)bl * SEQ;
    const int kr0 = tid >> 4, kc = tid & 15, vr0 = tid >> 3, vc = tid & 7;
    u32x4 sk0, sk1, sv0, sv1;
#define ATT_LOADK(t) do { const bf16_t* kp = Kg + (size_t)((t) * 64 + kr0) * 1024 + kc * 8; sk0 = *(const u32x4*)kp; sk1 = *(const u32x4*)(kp + 32 * 1024); } while (0)
#define ATT_LOADV(t) do { const bf16_t* vp = Vg + (size_t)vr0 * MG + (t) * 64 + vc * 8; sv0 = *(const u32x4*)vp; sv1 = *(const u32x4*)(vp + (size_t)64 * MG); } while (0)
#define ATT_WRITEK(b) do { LAS unsigned char* kb_ = lds + (b) * BUFB; *(LAS u32x4*)(kb_ + kr0 * KROW + kc * 16) = sk0; *(LAS u32x4*)(kb_ + (kr0 + 32) * KROW + kc * 16) = sk1; } while (0)
#define ATT_WRITEV(b) do { LAS unsigned char* kb_ = lds + (b) * BUFB; *(LAS u32x4*)(kb_ + KBUF + vr0 * VROW + vc * 16) = sv0; *(LAS u32x4*)(kb_ + KBUF + (vr0 + 64) * VROW + vc * 16) = sv1; } while (0)
    ATT_LOADK(0); ATT_LOADV(0); ATT_WRITEK(0); ATT_WRITEV(0);
    __syncthreads();
    f32x16 o[2][4];
#pragma unroll
    for (int mp = 0; mp < 2; ++mp)
#pragma unroll
        for (int eb = 0; eb < 4; ++eb)
#pragma unroll
            for (int r = 0; r < 16; ++r) o[mp][eb][r] = 0.f;
    float mref[2] = {0.f, 0.f}, lsum[2] = {0.f, 0.f};
    const int pi = (r32 & ~12) | ((r32 & 4) << 1) | ((r32 & 8) >> 1);
    const int koff = pi * KROW + hi * 16, qoff = r32 * KROW + hi * 16, voff = r32 * VROW + hi * 16;
    constexpr int NT = SEQ / 64;
#pragma unroll 1
    for (int t = 0; t < NT; ++t) {
        const int cur = t & 1;
        if (t + 1 < NT) ATT_LOADK(t + 1);
        LAS unsigned char* kb = lds + cur * BUFB; LAS unsigned char* vb = kb + KBUF;
        bf16x8 P[2][4];
#pragma unroll
        for (int mp = 0; mp < 2; ++mp) {
            bf16x8 qf[4];
#pragma unroll
            for (int ks = 0; ks < 4; ++ks) qf[ks] = *(LAS bf16x8*)(qlds + qoff + mp * 128 + ks * 32);
#pragma unroll
            for (int blk = 0; blk < 2; ++blk) {
                f32x16 s;
#pragma unroll
                for (int r = 0; r < 16; ++r) s[r] = 0.f;
#pragma unroll
                for (int ks = 0; ks < 4; ++ks) { const bf16x8 kf = *(LAS bf16x8*)(kb + blk * 32 * KROW + koff + mp * 128 + ks * 32); s = MFMA32(kf, qf[ks], s); }
                float rm = fmaxf(s[0], s[1]);
#pragma unroll
                for (int r = 2; r < 16; ++r) rm = fmaxf(rm, s[r]);
                rm = fmaxf(rm, __shfl_xor(rm, 32));
                const bool first = (t == 0 && blk == 0);
                if (first || __any(rm > mref[mp] + THR)) {
                    const float mnew = first ? rm : fmaxf(mref[mp], rm);
                    if (!first) {
                        const float alpha = __builtin_amdgcn_exp2f(mref[mp] - mnew);
                        lsum[mp] *= alpha;
                        if (hi == 0) wsf[r32] = alpha;
#pragma unroll
                        for (int r = 0; r < 16; ++r) { const float al = wsf[crow(r, hi)];
#pragma unroll
                            for (int eb = 0; eb < 4; ++eb) o[mp][eb][r] *= al; }
                        if (blk == 1) {
#pragma unroll
                            for (int j = 0; j < 2; ++j) { u32x4 w = __builtin_bit_cast(u32x4, P[mp][j]);
                                w.x = pkbf(bflo(w.x) * alpha, bfhi(w.x) * alpha); w.y = pkbf(bflo(w.y) * alpha, bfhi(w.y) * alpha);
                                w.z = pkbf(bflo(w.z) * alpha, bfhi(w.z) * alpha); w.w = pkbf(bflo(w.w) * alpha, bfhi(w.w) * alpha); P[mp][j] = __builtin_bit_cast(bf16x8, w); }
                        }
                    }
                    mref[mp] = mnew;
                }
                const float mm = mref[mp]; float ps = 0.f;
#pragma unroll
                for (int r = 0; r < 16; ++r) { const float p = __builtin_amdgcn_exp2f(s[r] - mm); s[r] = p; ps += p; }
                lsum[mp] += ps;
#pragma unroll
                for (int j = 0; j < 2; ++j) { u32x4 w; w.x = pkbf(s[8 * j], s[8 * j + 1]); w.y = pkbf(s[8 * j + 2], s[8 * j + 3]);
                    w.z = pkbf(s[8 * j + 4], s[8 * j + 5]); w.w = pkbf(s[8 * j + 6], s[8 * j + 7]); P[mp][2 * blk + j] = __builtin_bit_cast(bf16x8, w); }
            }
            __builtin_amdgcn_sched_barrier(0);
        }
        if (t + 1 < NT) { ATT_WRITEK(cur ^ 1); ATT_LOADV(t + 1); }
        __builtin_amdgcn_sched_barrier(0);
#pragma unroll
        for (int bj = 0; bj < 4; ++bj)
#pragma unroll
            for (int eb = 0; eb < 4; ++eb) { const bf16x8 vf = *(LAS bf16x8*)(vb + eb * 32 * VROW + voff + bj * 32);
                o[0][eb] = MFMA32(P[0][bj], vf, o[0][eb]); o[1][eb] = MFMA32(P[1][bj], vf, o[1][eb]); }
        if (t + 1 < NT) ATT_WRITEV(cur ^ 1);
        __syncthreads();
    }
#undef ATT_LOADK
#undef ATT_LOADV
#undef ATT_WRITEK
#undef ATT_WRITEV
    const float l0 = lsum[0] + __shfl_xor(lsum[0], 32), l1 = lsum[1] + __shfl_xor(lsum[1], 32);
    if (hi == 0) { wsf[r32] = 1.f / l0; wsf[32 + r32] = lam / l1; }
    float ss[16];
#pragma unroll
    for (int r = 0; r < 16; ++r) { const float a = wsf[crow(r, hi)], b = wsf[32 + crow(r, hi)]; float q = 0.f;
#pragma unroll
        for (int eb = 0; eb < 4; ++eb) { const float v = o[0][eb][r] * a - o[1][eb][r] * b; o[0][eb][r] = v; q += v * v; }
        ss[r] = q; }
#pragma unroll
    for (int r = 0; r < 16; ++r) {
#pragma unroll
        for (int sft = 1; sft < 32; sft <<= 1) ss[r] += __shfl_xor(ss[r], sft);
        ss[r] = __builtin_amdgcn_rsqf(ss[r] * (1.f / 128.f) + EPS) * (1.f - LAM_INIT);
    }
    float gsub[4];
#pragma unroll
    for (int eb = 0; eb < 4; ++eb) gsub[eb] = subg[eb * 32 + r32];
#pragma unroll
    for (int r = 0; r < 16; ++r) { const size_t off = (rowq0 + crow(r, hi)) * 1024 + h * 128 + r32;
#pragma unroll
        for (int eb = 0; eb < 4; ++eb) { const float z = __uint_as_float((unsigned)ZB[off + eb * 32] << 16);
            const float y = o[0][eb][r] * ss[r] * gsub[eb] * z; YB[off + eb * 32] = (bf16_t)(pkbf(y, 0.f) & 0xffffu); } }
}
}

namespace gm {
constexpr int TROW = 272;
__device__ __forceinline__ void unit(LAS unsigned char* lds, const bf16_t* __restrict__ V, const bf16_t* __restrict__ U, const bf16_t* __restrict__ SZA, bf16_t* __restrict__ YA,
                                     const float* __restrict__ lnsum, const float* __restrict__ lng, const float* __restrict__ lnb, const bf16_t* __restrict__ wsbf,
                                     const float* __restrict__ bs, int c, int h) {
    int tid_l = threadIdx.x; asm volatile("" : "+v"(tid_l));
    const int tid = tid_l, lane = tid & 63, wid = __builtin_amdgcn_readfirstlane(tid >> 6), r32 = lane & 31, hi = lane >> 5;
    const size_t row0 = (size_t)c * 128;
    {
        const int tok = tid & 127;
        const float sm = lnsum[(row0 + tok) * 2], sq = lnsum[(row0 + tok) * 2 + 1];
        const float mean = sm * (1.f / 1024.f), var = sq * (1.f / 1024.f) - mean * mean, rstd = __builtin_amdgcn_rsqf(fmaxf(var, 0.f) + EPS);
#pragma unroll
        for (int i = 0; i < 4; ++i) { const int dch = (tid >> 7) + 4 * i;
            const u32x4 raw = *(const u32x4*)(V + (row0 + tok) * 1024 + h * 128 + dch * 8);
            const unsigned w[4] = {raw.x, raw.y, raw.z, raw.w};
#pragma unroll
            for (int k = 0; k < 8; ++k) { const int d = dch * 8 + k; const float val = (k & 1) ? bfhi(w[k >> 1]) : bflo(w[k >> 1]);
                const float vn = (val - mean) * rstd * lng[h * 128 + d] + lnb[h * 128 + d];
                *(LAS bf16_t*)(lds + d * TROW + tok * 2) = (bf16_t)(pkbf(vn, 0.f) & 0xffffu); } }
    }
    __syncthreads();
    const int db = wid >> 1, ib0 = 2 * (wid & 1);
    f32x16 acc[2];
#pragma unroll
    for (int ii = 0; ii < 2; ++ii)
#pragma unroll
        for (int r = 0; r < 16; ++r) acc[ii][r] = 0.f;
#pragma unroll
    for (int ks = 0; ks < 8; ++ks) { const bf16x8 a = *(LAS bf16x8*)(lds + (32 * db + r32) * TROW + (16 * ks + 8 * hi) * 2);
#pragma unroll
        for (int ii = 0; ii < 2; ++ii) { const bf16x8 b = *(const bf16x8*)(wsbf + ((size_t)(h * 128 + 32 * (ib0 + ii) + r32) * 128 + 16 * ks + 8 * hi)); acc[ii] = MFMA32(a, b, acc[ii]); } }
#pragma unroll
    for (int ii = 0; ii < 2; ++ii) { const int i = 32 * (ib0 + ii) + r32; const float bsv = bs[h * 128 + i];
#pragma unroll
        for (int g4 = 0; g4 < 4; ++g4) { const size_t off = (row0 + i) * 1024 + h * 128 + 32 * db + 8 * g4 + 4 * hi;
            const u32x2 uu = *(const u32x2*)(U + off), zz = *(const u32x2*)(SZA + off);
            const float y0 = bflo(uu.x) * (acc[ii][4 * g4] + bsv) * bflo(zz.x), y1 = bfhi(uu.x) * (acc[ii][4 * g4 + 1] + bsv) * bfhi(zz.x);
            const float y2 = bflo(uu.y) * (acc[ii][4 * g4 + 2] + bsv) * bflo(zz.y), y3 = bfhi(uu.y) * (acc[ii][4 * g4 + 3] + bsv) * bfhi(zz.y);
            u32x2 w; w.x = pkbf(y0, y1); w.y = pkbf(y2, y3); *(u32x2*)(YA + off) = w; } }
    __syncthreads();
}
}

__device__ __forceinline__ int main_src_col(int n) {
    const int seg8 = n >> 10; int c = n & 1023; const int sseg = seg8 < 5 ? seg8 : seg8 + 1;
    if (seg8 == SEG_Q || seg8 == SEG_K) { const int p = c & 63; c = (c & ~63) | ((p >> 1) + 32 * (p & 1)); }
    return sseg * 1024 + c;
}
__device__ __forceinline__ void transpose_item(const float* __restrict__ W, int ldw, int mode, int coff, const float* __restrict__ gk, bf16_t* __restrict__ WT, int K, int nblk,
                                               LAS float* scr, int item, int lane) {
    const int kb = item / nblk, nb = item % nblk, k0 = 64 * kb, n0 = 32 * nb;
    const int nn = n0 + (lane & 31), srcc = mode ? main_src_col(nn) : coff + nn;
#pragma unroll 8
    for (int i = 0; i < 32; ++i) { const int kk = 2 * i + (lane >> 5); float w = W[(size_t)(k0 + kk) * ldw + srcc]; if (gk) w *= gk[k0 + kk]; scr[kk * 33 + (lane & 31)] = w; }
    asm volatile("s_waitcnt lgkmcnt(0)" ::: "memory");
    const int c = lane & 7;
#pragma unroll
    for (int j = 0; j < 4; ++j) { const int n = (lane >> 3) + 8 * j; const LAS float* s = scr + (8 * c) * 33 + n;
        u32x4 o; o.x = pkbf(s[0 * 33], s[1 * 33]); o.y = pkbf(s[2 * 33], s[3 * 33]); o.z = pkbf(s[4 * 33], s[5 * 33]); o.w = pkbf(s[6 * 33], s[7 * 33]);
        *(u32x4*)(WT + (size_t)(n0 + n) * K + k0 + 8 * c) = o; }
    asm volatile("s_waitcnt lgkmcnt(0)" ::: "memory");
}

#define XB_TMO      128
#define XB_XCNT(j)  (256  + 64 * (j))
#define XB_XSUB(j)  (1280 + 64 * (j))
#define XB_XGEN(j)  (2304 + 64 * (j))
#define XB_TOP      3328
#define XB_TOPGEN   3392
#define XCD_BAR_WORDS 3456
#define XB_SPIN_CAP (1u << 18)

__device__ __forceinline__ unsigned xb_ld(unsigned* p)              { return __hip_atomic_load(p, __ATOMIC_RELAXED, __HIP_MEMORY_SCOPE_AGENT); }
__device__ __forceinline__ unsigned xb_add(unsigned* p, unsigned v) { return __hip_atomic_fetch_add(p, v, __ATOMIC_RELAXED, __HIP_MEMORY_SCOPE_AGENT); }
__device__ __forceinline__ unsigned xb_xcc_id() { return (unsigned)__builtin_amdgcn_s_getreg((3 << 11) | 20) & 0xFu; }
#define XB_SPIN(cond, bar) do { unsigned _sp = 0; while (cond) { __builtin_amdgcn_s_sleep(1); \
    if ((++_sp & 255u) == 0u) { if (xb_ld(&(bar)[XB_TMO])) break; if (_sp > XB_SPIN_CAP) { atomicAdd(&(bar)[XB_TMO], 1u); break; } } } } while (0)

struct XcdBarrier {
    unsigned* bar; unsigned x;
    volatile LAS unsigned* st;
};

__device__ __forceinline__ XcdBarrier xcd_barrier_post(unsigned* bar, volatile LAS unsigned* st) {
    XcdBarrier b; b.bar = bar; b.x = xb_xcc_id(); b.st = st;
    if (threadIdx.x == 0) (void)xb_add(&bar[XB_XCNT(b.x)], 1u);
    return b;
}
__device__ __forceinline__ void xcd_barrier_complete(unsigned* bar, unsigned x, unsigned& nloc, unsigned& nx) {
    const unsigned G = gridDim.x * gridDim.y * gridDim.z;
    unsigned sum, cnt, mine, sp = 0u;
    for (;;) {
        sum = 0u; cnt = 0u; mine = 0u;
#pragma unroll
        for (unsigned j = 0; j < 16; ++j) { const unsigned c = xb_ld(&bar[XB_XCNT(j)]); sum += c; cnt += (c > 0u) ? 1u : 0u; mine = (j == x) ? c : mine; }
        if (sum == G) break;
        __builtin_amdgcn_s_sleep(1);
        if ((++sp & 255u) == 0u) { if (xb_ld(&bar[XB_TMO])) break; if (sp > XB_SPIN_CAP) { atomicAdd(&bar[XB_TMO], 1u); break; } }
    }
    nloc = mine > 0u ? mine : 1u; nx = cnt > 0u ? cnt : 1u;
}

__device__ __forceinline__ void xcd_barrier(const XcdBarrier& b) {
    asm volatile("s_waitcnt vmcnt(0)" ::: "memory");
    __syncthreads();
    if (threadIdx.x == 0) {
        unsigned* bar = b.bar;
        __builtin_amdgcn_s_waitcnt(0);
        unsigned nloc = b.st[0], nx = b.st[1];
        if (nloc == 0u) { xcd_barrier_complete(bar, b.x, nloc, nx); b.st[0] = nloc; b.st[1] = nx; }
        const unsigned old = xb_add(&bar[XB_XSUB(b.x)], 1u);
        const unsigned gen = old / nloc;
        if (old + 1u == (gen + 1u) * nloc) {
            __builtin_amdgcn_fence(__ATOMIC_RELEASE, "agent");
            asm volatile("s_waitcnt vmcnt(0)" ::: "memory");
            const unsigned og = xb_add(&bar[XB_TOP], 1u);
            const unsigned tg = og / nx;
            if (og + 1u == (tg + 1u) * nx) xb_add(&bar[XB_TOPGEN], 1u);
            else XB_SPIN(xb_ld(&bar[XB_TOPGEN]) == tg, bar);
            __builtin_amdgcn_fence(__ATOMIC_ACQUIRE, "agent");
            xb_add(&bar[XB_XGEN(b.x)], 1u);
            asm volatile("s_waitcnt vmcnt(0)" ::: "memory");
        } else {
            XB_SPIN(xb_ld(&bar[XB_XGEN(b.x)]) == gen, bar);
            __builtin_amdgcn_fence(__ATOMIC_ACQUIRE, "agent");
            asm volatile("s_waitcnt vmcnt(0)" ::: "memory");
        }
    }
    __syncthreads();
}

struct Args { const float* in[16]; float* out; unsigned char* ws; int ph_lo, ph_hi; };
enum { IN_X = 0, IN_LNPRE, IN_WIN, IN_GMLNG, IN_GMLNB, IN_GMWS, IN_GMBS, IN_LQ1, IN_LK1, IN_LQ2, IN_LK2, IN_SUBG, IN_WA, IN_WB, IN_WOUT, IN_LNPOST };
constexpr int N_PHASES = 2 + 4 * NGROUP;

__global__ void __launch_bounds__(512, 2) fwd_kernel(Args a) {
    extern __shared__ __attribute__((aligned(16))) unsigned char lds_raw[];
    LAS unsigned char* lds = (LAS unsigned char*)lds_raw;
    const int tid = threadIdx.x, lane = tid & 63, wid = __builtin_amdgcn_readfirstlane(tid >> 6);
    const int G = gridDim.x, bx = blockIdx.x;
    const int vcu = (G % 8 == 0) ? (bx % 8) * (G / 8) + bx / 8 : bx;
    unsigned char* ws = a.ws;
    bf16_t* Wmain = (bf16_t*)(ws + WS_WMAIN); bf16_t* Wvv = (bf16_t*)(ws + WS_WVV); bf16_t* Wa = (bf16_t*)(ws + WS_WA); bf16_t* Wb = (bf16_t*)(ws + WS_WB); bf16_t* Wout = (bf16_t*)(ws + WS_WOUT);
    bf16_t* gmws = (bf16_t*)(ws + WS_GMWS); float* rope = (float*)(ws + WS_ROPE); float* lnsum = (float*)(ws + WS_LNSUM); float* rowss = (float*)(ws + WS_ROWSS);
    bf16_t* XN = (bf16_t*)(ws + WS_XN); bf16_t* PROJ = (bf16_t*)(ws + WS_PROJ); bf16_t* VT = (bf16_t*)(ws + WS_VT); bf16_t* YA = (bf16_t*)(ws + WS_YA); bf16_t* YB = (bf16_t*)(ws + WS_YB);
    float* TMP = (float*)(ws + WS_TMP); bf16_t* MERGED = (bf16_t*)(ws + WS_MERGED);
    const int lo = a.ph_lo, hi_ph = a.ph_hi;
    volatile LAS unsigned* bst = (volatile LAS unsigned*)(lds + LDS_BYTES - 64);
    if (tid == 0) { bst[0] = 0u; bst[1] = 0u; }
    __syncthreads();
    unsigned* barw = (unsigned*)ws + 4096;
    XcdBarrier xbar; xbar.bar = barw; xbar.x = 0; xbar.st = bst;
#define IN(k) (lo <= (k) && (k) < hi_ph)
#define SYNC(k) do { if (MK_N_LAUNCHES == 1) { if ((k) + 1 < hi_ph) xcd_barrier(xbar); } } while (0)
    const int gw = vcu * 8 + wid, NGW = G * 8;

    if (IN(0)) {
        if (bx == 0) for (int i = tid; i < XCD_BAR_WORDS; i += 512) barw[i] = 0u;
        LAS float* scr = (LAS float*)(lds + wid * 16384);
        constexpr int I_MAIN = 16 * (NMAIN / 32), I_SQ = 16 * 32;
        for (int it = gw; it < I_MAIN + 4 * I_SQ; it += NGW) {
            int r = it;
            if (r < I_MAIN) { transpose_item(a.in[IN_WIN], 9216, 1, 0, a.in[IN_LNPRE], Wmain, 1024, NMAIN / 32, scr, r, lane); continue; } r -= I_MAIN;
            if (r < I_SQ) { transpose_item(a.in[IN_WIN], 9216, 0, 5120, a.in[IN_LNPRE], Wvv, 1024, 32, scr, r, lane); continue; } r -= I_SQ;
            if (r < I_SQ) { transpose_item(a.in[IN_WA], 1024, 0, 0, nullptr, Wa, 1024, 32, scr, r, lane); continue; } r -= I_SQ;
            if (r < I_SQ) { transpose_item(a.in[IN_WB], 1024, 0, 0, nullptr, Wb, 1024, 32, scr, r, lane); continue; } r -= I_SQ;
            transpose_item(a.in[IN_WOUT], 1024, 0, 0, nullptr, Wout, 1024, 32, scr, r, lane);
        }
        const float* x = a.in[IN_X];
        for (int m = gw; m < MTOT; m += NGW) {
            const f32x4* xr = (const f32x4*)(x + (size_t)m * 1024) + lane; f32x4 v[4]; float s = 0.f;
#pragma unroll
            for (int j = 0; j < 4; ++j) { v[j] = xr[64 * j]; s += (v[j][0] * v[j][0] + v[j][1] * v[j][1]) + (v[j][2] * v[j][2] + v[j][3] * v[j][3]); }
            const float rstd = 1.f / sqrtf(wave_sum(s) * (1.f / 1024.f) + EPS);
            u32x2* o8 = (u32x2*)(XN + (size_t)m * 1024) + lane;
#pragma unroll
            for (int j = 0; j < 4; ++j) { u32x2 w; w.x = pkbf(v[j][0] * rstd, v[j][1] * rstd); w.y = pkbf(v[j][2] * rstd, v[j][3] * rstd); o8[64 * j] = w; }
        }
        const int gt = vcu * 512 + tid, NGT = G * 512;
        for (int i = gt; i < SEQ * 32; i += NGT) { const int pos = i >> 5, fi = i & 31;
            const double inv = exp(-(double)fi * (9.210340371976184 / 32.0)); const double ang = (double)pos * inv;
            rope[2 * i] = (float)cos(ang); rope[2 * i + 1] = (float)sin(ang); }
        for (int i = gt; i < MTOT * 2; i += NGT) lnsum[i] = 0.f;
        for (int i = gt; i < MTOT; i += NGT) rowss[i] = 0.f;
        const float* gws = a.in[IN_GMWS];
        for (int i = gt; i < 8 * 128 * 128 / 2; i += NGT) ((unsigned*)gmws)[i] = pkbf(gws[2 * i], gws[2 * i + 1]);
        if (MK_N_LAUNCHES == 1) { cg::this_grid().sync(); xbar = xcd_barrier_post(barw, bst); }
    }

#pragma unroll 1
    for (int g = 0; g < NGROUP; ++g) {
        const bf16_t* XNg = XN + (size_t)g * MG * 1024;
        if (IN(1 + 4 * g)) {
            { pg8::Gemm gm_{XNg, Wmain, MG, NMAIN, 1024}; pg8::StaticOrder S; S.init(MG, NMAIN, G, bx);
              EpiProj E{PROJ, rope, lnsum + (size_t)g * MG * 2};
              pg8::gemm_phase<EpiProj, pg8::StaticOrder, true, true>(lds, gm_, S, E); }
            { pg8::Gemm gm_{Wvv, XNg, 1024, MG, 1024}; pg8::StaticOrder S; S.init(1024, MG, G, bx);
              EpiPlain E{VT, MG};
              pg8::gemm_phase<EpiPlain, pg8::StaticOrder, false, true>(lds, gm_, S, E); }
            SYNC(1 + 4 * g);
        }
        if (IN(2 + 4 * g)) {
            int ln = threadIdx.x & 63; asm volatile("" : "+v"(ln));
            const float t1 = wave_sum(a.in[IN_LQ1][ln] * a.in[IN_LK1][ln]), t2 = wave_sum(a.in[IN_LQ2][ln] * a.in[IN_LK2][ln]);
            const float lam = __expf(t1) - __expf(t2) + LAM_INIT;
            for (int ui = vcu; ui < BPG * 8 * 8; ui += G) { const int bh = ui >> 3, qb = ui & 7;
                att::attn_unit(lds, PROJ + SEG_Q * SEG_ELEMS, PROJ + SEG_K * SEG_ELEMS, VT, PROJ + SEG_ZB * SEG_ELEMS, YB, a.in[IN_SUBG], lam, bh >> 3, bh & 7, qb); }
            __syncthreads();
            for (int ui = vcu; ui < (MG / 128) * 8; ui += G) { const int c = ui >> 3, h = ui & 7;
                gm::unit(lds, PROJ + SEG_V * SEG_ELEMS, PROJ + SEG_U * SEG_ELEMS, PROJ + SEG_ZA * SEG_ELEMS, YA, lnsum + (size_t)g * MG * 2, a.in[IN_GMLNG], a.in[IN_GMLNB], gmws, a.in[IN_GMBS], c, h); }
            SYNC(2 + 4 * g);
        }
        if (IN(3 + 4 * g)) {
            { pg8::Gemm gm_{YA, Wa, MG, 1024, 1024}; pg8::StaticOrder S; S.init(MG, 1024, G, bx);
              EpiGateA E{PROJ + SEG_GA * SEG_ELEMS, TMP};
              pg8::gemm_phase<EpiGateA, pg8::StaticOrder, false, true>(lds, gm_, S, E); }
            { pg8::Gemm gm_{YB, Wb, MG, 1024, 1024}; pg8::StaticOrder S; S.init(MG, 1024, G, bx);
              EpiGateB E{PROJ + SEG_GB * SEG_ELEMS, TMP, MERGED};
              pg8::gemm_phase<EpiGateB, pg8::StaticOrder, false, true>(lds, gm_, S, E); }
            SYNC(3 + 4 * g);
        }
        if (IN(4 + 4 * g)) {
            pg8::Gemm gm_{MERGED, Wout, MG, 1024, 1024}; pg8::StaticOrder S; S.init(MG, 1024, G, bx);
            EpiOut E{a.out + (size_t)g * MG * 1024, rowss + (size_t)g * MG};
            pg8::gemm_phase<EpiOut, pg8::StaticOrder, false, true>(lds, gm_, S, E);
            if (g == NGROUP - 1) SYNC(4 + 4 * g);
        }
    }
    if (IN(N_PHASES - 1)) {
        const float* x = a.in[IN_X]; const float* gp = a.in[IN_LNPOST];
        f32x4 gv[4];
#pragma unroll
        for (int j = 0; j < 4; ++j) gv[j] = ((const f32x4*)gp)[64 * j + lane];
        for (int m = gw; m < MTOT; m += NGW) {
            const float rs = 1.f / sqrtf(rowss[m] * (1.f / 1024.f) + EPS);
            const f32x4* xr = (const f32x4*)(x + (size_t)m * 1024) + lane; f32x4* orow = (f32x4*)(a.out + (size_t)m * 1024) + lane;
#pragma unroll
            for (int j = 0; j < 4; ++j) { const f32x4 ov = orow[64 * j]; orow[64 * j] = xr[64 * j] + ov * rs * gv[j]; }
        }
    }
#undef IN
#undef SYNC
}

extern "C" void kernel_launch(void* const* d_in, const int* in_sizes, int n_in, void* d_out, int out_size, void* d_ws, size_t ws_size, hipStream_t stream) {
    static int grid = 0;
    if (grid == 0) {
        if (n_in != 16 || in_sizes[0] != MTOT * DMOD || out_size != MTOT * DMOD || ws_size < WS_END) { fprintf(stderr, "kernel_launch: unexpected shapes / workspace (n_in %d, ws %zu)\n", n_in, ws_size); grid = -1; return; }
        int dev = 0, cus = 0, per_cu = 0;
        hipGetDevice(&dev); hipDeviceGetAttribute(&cus, hipDeviceAttributeMultiprocessorCount, dev);
        if (hipFuncSetAttribute((const void*)fwd_kernel, hipFuncAttributeMaxDynamicSharedMemorySize, LDS_BYTES) != hipSuccess) { fprintf(stderr, "kernel_launch: hipFuncSetAttribute failed\n"); grid = -1; return; }
        if (hipOccupancyMaxActiveBlocksPerMultiprocessor(&per_cu, (const void*)fwd_kernel, 512, LDS_BYTES) != hipSuccess || per_cu < 1) { fprintf(stderr, "kernel_launch: occupancy query gave %d\n", per_cu); per_cu = 1; }
        (void)hipGetLastError();
        grid = cus * per_cu;
    }
    if (grid < 0) return;
    Args a{};
    for (int i = 0; i < 16; ++i) a.in[i] = (const float*)d_in[i];
    a.out = (float*)d_out; a.ws = (unsigned char*)d_ws;
#if MK_N_LAUNCHES == 1
    a.ph_lo = 0; a.ph_hi = N_PHASES;
    void* args[] = {&a};
    hipError_t e = hipLaunchCooperativeKernel((const void*)fwd_kernel, dim3(grid), dim3(512), args, LDS_BYTES, stream);
    if (e != hipSuccess) fprintf(stderr, "kernel_launch: cooperative launch failed: %s (grid %d)\n", hipGetErrorString(e), grid);
#else
    for (int p = 0; p < N_PHASES; ++p) { a.ph_lo = p; a.ph_hi = p + 1; hipLaunchKernelGGL(fwd_kernel, dim3(grid), dim3(512), LDS_BYTES, stream, a); }
#endif
}
```
